# Optimizing an MI355X kernel written in HIP

```python
import math
import jax, jax.numpy as jnp
from jax import lax
import numpy as np

D_MODEL = 2048
BATCH = 4
SEQ = 4096
DEPTH = 1
DEC_BATCH = 16
DEC_SEQ = 2048
PAST_LEN = 128

SSM_WIDTH = 1024
SSM_GROUP = 16
SSM_GROUPS = SSM_WIDTH // SSM_GROUP
SSM_STATE = 64
ATT_HEADS = 4
ATT_HEAD_DIM = 128
ATT_V_DIM = 2 * ATT_HEAD_DIM
ATT_QK_WIDTH = ATT_HEADS * 2 * ATT_HEAD_DIM
ATT_WIDTH = ATT_HEADS * ATT_V_DIM
Q_BLOCK = 128
NUM_BUCKETS = 32
MAX_DISTANCE = 128
PLE_DIM = 256
IN_WIDTH = 2 * SSM_WIDTH + 2 * ATT_QK_WIDTH + 2 * ATT_WIDTH + 2 * D_MODEL
EPS = 1e-6

kernel_name = "hybrid_s5_diffattn_encoder"


def rmsnorm(x, g):
    xf = x.astype(jnp.float32)
    y = xf * lax.rsqrt(jnp.mean(xf * xf, axis=-1, keepdims=True) + EPS) * g.astype(jnp.float32)
    return y.astype(x.dtype)


def rel_bucket(rel):
    half = NUM_BUCKETS // 2
    max_exact = half // 2
    ret = (rel > 0).astype(jnp.int32) * half
    n = jnp.abs(rel)
    nf = jnp.maximum(n, 1).astype(jnp.float32)
    large = max_exact + (jnp.log(nf / max_exact) / math.log(MAX_DISTANCE / max_exact)
                         * (half - max_exact)).astype(jnp.int32)
    large = jnp.minimum(large, half - 1)
    return ret + jnp.where(n < max_exact, n, large)


def _scan_combine(e1, e2):
    a1r, a1i, b1r, b1i = e1
    a2r, a2i, b2r, b2i = e2
    ar = a1r * a2r - a1i * a2i
    ai = a1r * a2i + a1i * a2r
    br = a2r * b1r - a2i * b1i + b2r
    bi = a2r * b1i + a2i * b1r + b2i
    return ar, ai, br, bi


def s5_direction(u, lam_re, lam_im, log_dt, b_re, b_im, c_re, c_im, reverse):
    lam_re = lam_re.astype(jnp.float32)
    lam_im = lam_im.astype(jnp.float32)
    dt = jnp.exp(log_dt.astype(jnp.float32))[:, None]
    mag = jnp.exp(lam_re * dt)
    ab_re = mag * jnp.cos(lam_im * dt)
    ab_im = mag * jnp.sin(lam_im * dt)
    den = lam_re * lam_re + lam_im * lam_im
    nr = ab_re - 1.0
    ni = ab_im
    k_re = (nr * lam_re + ni * lam_im) / den
    k_im = (ni * lam_re - nr * lam_im) / den
    b_re = b_re.astype(jnp.float32)
    b_im = b_im.astype(jnp.float32)
    bb_re = k_re[..., None] * b_re - k_im[..., None] * b_im
    bb_im = k_re[..., None] * b_im + k_im[..., None] * b_re
    if reverse:
        u = jnp.flip(u, axis=1)
    br = jnp.einsum('blgc,gnc->lbgn', u, bb_re)
    bi = jnp.einsum('blgc,gnc->lbgn', u, bb_im)
    l = u.shape[1]
    ar = jnp.broadcast_to(ab_re, (l, 1) + ab_re.shape)
    ai = jnp.broadcast_to(ab_im, (l, 1) + ab_im.shape)
    _, _, hr, hi = lax.associative_scan(_scan_combine, (ar, ai, br, bi), axis=0)
    y = (jnp.einsum('lbgn,gcn->blgc', hr, c_re.astype(jnp.float32))
         - jnp.einsum('lbgn,gcn->blgc', hi, c_im.astype(jnp.float32)))
    if reverse:
        y = jnp.flip(y, axis=1)
    return y


def diff_attention(q, k, v, rel_bias, lam):
    b, l = q.shape[0], q.shape[1]
    nb = l // Q_BLOCK
    scale = ATT_HEAD_DIM ** -0.5
    qb = q.reshape(b, nb, Q_BLOCK, ATT_HEADS, 2, ATT_HEAD_DIM).swapaxes(0, 1)
    starts = jnp.arange(nb, dtype=jnp.int32) * Q_BLOCK
    kpos = jnp.arange(l, dtype=jnp.int32)
    vf = v.astype(jnp.float32)

    def block(args):
        qi, start = args
        qpos = start + jnp.arange(Q_BLOCK, dtype=jnp.int32)
        bias = rel_bias[rel_bucket(kpos[None, :] - qpos[:, None])].astype(jnp.float32)
        bias = jnp.transpose(bias, (2, 0, 1))
        s = jnp.einsum('bqhcd,bkhcd->bhcqk', qi, k).astype(jnp.float32) * scale + bias[None, :, None]
        pr = jax.nn.softmax(s, axis=-1)
        w = pr[:, :, 0] - lam * pr[:, :, 1]
        return jnp.einsum('bhqk,bkhe->bqhe', w, vf)

    o = lax.map(block, (qb, starts))
    return o.swapaxes(0, 1).reshape(b, l, ATT_HEADS, ATT_V_DIM)


def trunk(x, p, rel_bias, norm_g, w_in, ssm_lambda_re, ssm_lambda_im, ssm_log_dt,
          ssm_b_re, ssm_b_im, ssm_c_re, ssm_c_im, ssm_d, glu_w, glu_b,
          lam_q1, lam_k1, lam_q2, lam_k2, subln_g, w_branch_s, w_branch_a, w_out,
          ple_norm_g, ple_gate_w, ple_proj_w, final_g):
    b, l = x.shape[0], x.shape[1]
    h = x
    sizes = (SSM_WIDTH, SSM_WIDTH, ATT_QK_WIDTH, ATT_QK_WIDTH, ATT_WIDTH, ATT_WIDTH, D_MODEL, D_MODEL)
    cuts = [int(c) for c in np.cumsum(sizes)[:-1]]
    for i in range(DEPTH):
        hn = rmsnorm(h, norm_g[i])
        proj = hn @ w_in[i]
        s_x, s_z, q, k, v, a_z, g_s, g_a = jnp.split(proj, cuts, axis=-1)

        u = s_x.astype(jnp.float32).reshape(b, l, SSM_GROUPS, SSM_GROUP)
        y = (s5_direction(u, ssm_lambda_re[i, 0], ssm_lambda_im[i, 0], ssm_log_dt[i, 0],
                          ssm_b_re[i, 0], ssm_b_im[i, 0], ssm_c_re[i, 0], ssm_c_im[i, 0], False)
             + s5_direction(u, ssm_lambda_re[i, 1], ssm_lambda_im[i, 1], ssm_log_dt[i, 1],
                            ssm_b_re[i, 1], ssm_b_im[i, 1], ssm_c_re[i, 1], ssm_c_im[i, 1], True)
             + ssm_d[i].astype(jnp.float32).reshape(SSM_GROUPS, SSM_GROUP) * u)
        y = jax.nn.gelu(y.reshape(b, l, SSM_WIDTH))
        y = y * jax.nn.sigmoid(y @ glu_w[i].astype(jnp.float32) + glu_b[i].astype(jnp.float32))
        y = (y * jax.nn.silu(s_z.astype(jnp.float32))).astype(x.dtype)
        y_s = y @ w_branch_s[i]

        lam_init = 0.8 - 0.6 * math.exp(-0.3 * i)
        lam = (jnp.exp(jnp.sum(lam_q1[i].astype(jnp.float32) * lam_k1[i].astype(jnp.float32)))
               - jnp.exp(jnp.sum(lam_q2[i].astype(jnp.float32) * lam_k2[i].astype(jnp.float32)))
               + lam_init)
        qh = q.reshape(b, l, ATT_HEADS, 2, ATT_HEAD_DIM)
        kh = k.reshape(b, l, ATT_HEADS, 2, ATT_HEAD_DIM)
        vh = v.reshape(b, l, ATT_HEADS, ATT_V_DIM)
        o = diff_attention(qh, kh, vh, rel_bias, lam)
        o = rmsnorm(o, subln_g[i]) * (1.0 - lam_init)
        o = (o.reshape(b, l, ATT_WIDTH) * jax.nn.silu(a_z.astype(jnp.float32))).astype(x.dtype)
        y_a = o @ w_branch_a[i]

        merged = jax.nn.sigmoid(g_s) * y_s + jax.nn.sigmoid(g_a) * y_a
        h = h + (merged @ w_out[i]).astype(h.dtype)

        gate = jax.nn.sigmoid(rmsnorm(h, ple_norm_g[i]) @ ple_gate_w[i])
        h = h + (gate * (p[i] @ ple_proj_w[i])).astype(h.dtype)
    return rmsnorm(h, final_g)


def setup_inputs(seed: int = 0) -> dict:
    key = jax.random.key(seed)
    ks = jax.random.split(key, 32)
    f32 = jnp.float32
    nrm = lambda k, s, sc: jax.random.normal(k, s, f32) * sc
    n_idx = jnp.arange(SSM_STATE, dtype=f32)
    lam_re = -0.5 + nrm(ks[8], (DEPTH, 2, SSM_GROUPS, SSM_STATE), 0.01)
    lam_im = math.pi * n_idx + nrm(ks[9], (DEPTH, 2, SSM_GROUPS, SSM_STATE), 0.01)
    log_dt = jax.random.uniform(ks[10], (DEPTH, 2, SSM_GROUPS), f32, math.log(1e-3), math.log(1e-1))
    return {
        "x_prompt": nrm(ks[0], (BATCH, SEQ, D_MODEL), 1.0),
        "x_sample": nrm(ks[1], (DEC_BATCH, DEC_SEQ, D_MODEL), 1.0),
        "p_prompt": nrm(ks[2], (DEPTH, BATCH, SEQ, PLE_DIM), 1.0),
        "p_sample": nrm(ks[3], (DEPTH, DEC_BATCH, DEC_SEQ, PLE_DIM), 1.0),
        "rel_bias": nrm(ks[4], (NUM_BUCKETS, ATT_HEADS), 0.5),
        "norm_g": 1.0 + nrm(ks[5], (DEPTH, D_MODEL), 0.02),
        "w_in": nrm(ks[6], (DEPTH, D_MODEL, IN_WIDTH), D_MODEL ** -0.5),
        "ssm_lambda_re": lam_re,
        "ssm_lambda_im": lam_im,
        "ssm_log_dt": log_dt,
        "ssm_b_re": nrm(ks[11], (DEPTH, 2, SSM_GROUPS, SSM_STATE, SSM_GROUP), (2 * SSM_GROUP) ** -0.5),
        "ssm_b_im": nrm(ks[12], (DEPTH, 2, SSM_GROUPS, SSM_STATE, SSM_GROUP), (2 * SSM_GROUP) ** -0.5),
        "ssm_c_re": nrm(ks[13], (DEPTH, 2, SSM_GROUPS, SSM_GROUP, SSM_STATE), (2 * SSM_STATE) ** -0.5),
        "ssm_c_im": nrm(ks[14], (DEPTH, 2, SSM_GROUPS, SSM_GROUP, SSM_STATE), (2 * SSM_STATE) ** -0.5),
        "ssm_d": nrm(ks[15], (DEPTH, SSM_WIDTH), 1.0),
        "glu_w": nrm(ks[16], (DEPTH, SSM_WIDTH, SSM_WIDTH), SSM_WIDTH ** -0.5),
        "glu_b": nrm(ks[17], (DEPTH, SSM_WIDTH), 0.02),
        "lam_q1": nrm(ks[18], (DEPTH, ATT_HEAD_DIM), 0.1),
        "lam_k1": nrm(ks[19], (DEPTH, ATT_HEAD_DIM), 0.1),
        "lam_q2": nrm(ks[20], (DEPTH, ATT_HEAD_DIM), 0.1),
        "lam_k2": nrm(ks[21], (DEPTH, ATT_HEAD_DIM), 0.1),
        "subln_g": 1.0 + nrm(ks[22], (DEPTH, ATT_V_DIM), 0.02),
        "w_branch_s": nrm(ks[23], (DEPTH, SSM_WIDTH, D_MODEL), SSM_WIDTH ** -0.5),
        "w_branch_a": nrm(ks[24], (DEPTH, ATT_WIDTH, D_MODEL), ATT_WIDTH ** -0.5),
        "w_out": nrm(ks[25], (DEPTH, D_MODEL, D_MODEL), D_MODEL ** -0.5),
        "ple_norm_g": 1.0 + nrm(ks[26], (DEPTH, D_MODEL), 0.02),
        "ple_gate_w": nrm(ks[27], (DEPTH, D_MODEL, D_MODEL), D_MODEL ** -0.5),
        "ple_proj_w": nrm(ks[28], (DEPTH, PLE_DIM, D_MODEL), PLE_DIM ** -0.5),
        "final_g": 1.0 + nrm(ks[29], (D_MODEL,), 0.02),
    }


def reference(x_prompt, x_sample, p_prompt, p_sample, rel_bias, norm_g, w_in,
              ssm_lambda_re, ssm_lambda_im, ssm_log_dt, ssm_b_re, ssm_b_im, ssm_c_re, ssm_c_im,
              ssm_d, glu_w, glu_b, lam_q1, lam_k1, lam_q2, lam_k2, subln_g,
              w_branch_s, w_branch_a, w_out, ple_norm_g, ple_gate_w, ple_proj_w, final_g):
    weights = (rel_bias, norm_g, w_in, ssm_lambda_re, ssm_lambda_im, ssm_log_dt,
               ssm_b_re, ssm_b_im, ssm_c_re, ssm_c_im, ssm_d, glu_w, glu_b,
               lam_q1, lam_k1, lam_q2, lam_k2, subln_g, w_branch_s, w_branch_a, w_out,
               ple_norm_g, ple_gate_w, ple_proj_w, final_g)
    y_prompt = trunk(x_prompt, p_prompt, *weights)
    y_sample = trunk(x_sample, p_sample, *weights)
    return (y_prompt, y_sample)
```

```cpp
#include <hip/hip_runtime.h>
#include <hip/hip_cooperative_groups.h>
#include <cstdio>
#include <cstdint>
namespace cg = cooperative_groups;

#define LAS __attribute__((address_space(3)))
typedef unsigned short bf16_t;
typedef short bf16x8 __attribute__((ext_vector_type(8)));
typedef short s16x4 __attribute__((ext_vector_type(4)));
typedef float f32x2 __attribute__((ext_vector_type(2)));
typedef float f32x4 __attribute__((ext_vector_type(4)));
typedef float f32x16 __attribute__((ext_vector_type(16)));
typedef unsigned u32x2 __attribute__((ext_vector_type(2)));
typedef unsigned u32x4 __attribute__((ext_vector_type(4)));

constexpr int T_P = 16384, T_ALL = 49152, DM = 2048, INW = 10240, PLE = 256;
constexpr int COL_SX = 0, COL_SZ = 1024, COL_Q = 2048, COL_K = 3072, COL_V = 4096, COL_AZ = 5120, COL_GS = 6144, COL_GA = 8192;
constexpr int COL_HB = 2048, COL_PP = 4096, COL_H2 = 0;
constexpr float EPS = 1e-6f;
constexpr float LOG2E = 1.4426950408889634f;
constexpr size_t MiB = 1048576;
constexpr size_t WS_P = 0;
constexpr size_t WS_WGLU = 960 * MiB;
constexpr size_t WS_WBS = WS_WGLU + 2 * MiB;
constexpr size_t WS_WBA = WS_WBS + 4 * MiB;
constexpr size_t WS_WOUT = WS_WBA + 4 * MiB;
constexpr size_t WS_WPG = WS_WOUT + 8 * MiB;
constexpr size_t WS_WPP = WS_WPG + 8 * MiB;
constexpr size_t WS_PB = WS_WPP + 1 * MiB;
constexpr size_t WS_RSTD1 = WS_PB + 24 * MiB;
constexpr size_t WS_SS2 = WS_RSTD1 + 256 * 1024;
constexpr size_t WS_SS3 = WS_SS2 + 256 * 1024;
constexpr size_t WS_BIAS = WS_SS3 + 256 * 1024;
constexpr size_t WS_MISC = WS_BIAS + 8192;
constexpr size_t WS_BAR = WS_MISC + 4096;
constexpr size_t WS_END = WS_BAR + 16384;
constexpr size_t DO_XB = 0;
constexpr size_t DO_WIN = 192 * MiB;
constexpr size_t DO_YF = 0;
constexpr size_t DO_OSC = 192 * MiB;
constexpr size_t DO_Y2 = 0;

struct Params { const float* in[29]; float* out; unsigned char* ws; };

__device__ __forceinline__ unsigned cvt_pk_bf16(float lo, float hi) { unsigned r; asm volatile("v_cvt_pk_bf16_f32 %0, %1, %2" : "=v"(r) : "v"(lo), "v"(hi)); return r; }
__device__ __forceinline__ float bf_lo(unsigned w) { return __uint_as_float(w << 16); }
__device__ __forceinline__ float bf_hi(unsigned w) { return __uint_as_float(w & 0xffff0000u); }
__device__ __forceinline__ float sigmoidf_(float x) { return __builtin_amdgcn_rcpf(1.0f + __builtin_amdgcn_exp2f(-x * LOG2E)); }
__device__ __forceinline__ float siluf_(float x) { return x * sigmoidf_(x); }
__device__ __forceinline__ float gelu_tanh(float x) { const float z = 0.7978845608028654f * (x + 0.044715f * x * x * x); return x * sigmoidf_(2.0f * z); }
__device__ __forceinline__ float wave_sum(float v) {
#pragma unroll
    for (int o = 32; o > 0; o >>= 1) v += __shfl_xor(v, o);
    return v;
}

namespace pg8 {
constexpr int BM = 256, BK = 64, HALF = 128, HTB = HALF * BK * 2, STAGE_BYTES = 8 * HTB, NXCD = 8, WGM = 8;
__host__ __device__ __forceinline__ int lds_byte(int r, int c) { const int st = (r >> 4) * 2 + (c >> 5), rr = r & 15, cc = c & 31, ob = rr * 64 + cc * 2; return st * 1024 + (ob ^ (((ob >> 9) & 1) << 5)); }
__host__ __device__ __forceinline__ void stage_rc(int b, int& R, int& C) { const int st = b / 1024, sb = b % 1024, swz = sb ^ (((sb >> 9) & 1) << 5); R = (st >> 1) * 16 + swz / 64; C = (st & 1) * 32 + (swz % 64) / 2; }
__host__ __device__ __forceinline__ int perm32(int rho) { const int n = rho >> 4, i = rho & 15; return 8 * (i >> 2) + 4 * n + (i & 3); }
struct Unit { int pm, pn; };
struct Gemm { const bf16_t* A; int lda; const bf16_t* Bt; int M, N, K; };
struct StaticOrder {
    int nM, nN, nwg, G, c;
    __device__ void init(int M, int N, int G_, int c_) { nM = M / BM; nN = N / BM; nwg = nM * nN; G = G_; c = c_; }
    __device__ bool next(int i, Unit& u) const {
        const long L = (long)i * G + c; if (L >= nwg) return false;
        int wgid = (int)L; { const int q = nwg / NXCD, r = nwg % NXCD, xcd = wgid % NXCD, off = wgid / NXCD; wgid = (xcd < r ? xcd * (q + 1) : r * (q + 1) + (xcd - r) * q) + off; }
        const int nig = WGM * nN, gid = wgid / nig, fm = gid * WGM, gsz = (nM - fm) < WGM ? (nM - fm) : WGM;
        u.pm = fm + ((wgid % nig) % gsz); u.pn = (wgid % nig) / gsz; return true;
    }
};

template <class Epi>
__device__ __forceinline__ void gemm_phase(LAS unsigned char* lds, const Gemm g, const StaticOrder& S, const Epi& E) {
    int tid = threadIdx.x; asm volatile("" : "+v"(tid));
    const int wid = __builtin_amdgcn_readfirstlane(tid >> 6), lane = tid & 63, wr = wid >> 2, wc = wid & 3, fr = lane & 15, fq = lane >> 4;
    const int K = g.K, nt = K / BK, lda = g.lda;
    unsigned voffA[2], voffB[2];
#pragma unroll
    for (int i = 0; i < 2; ++i) { int R, C; stage_rc(tid * 16 + i * 8192, R, C); const int Rb = Epi::PERM ? ((R & ~31) + perm32(R & 31)) : R;
        voffA[i] = (unsigned)(R * lda + C) * 2u; voffB[i] = (unsigned)(Rb * K + C) * 2u; }
    const size_t kstep = (size_t)(BK * 2);
    const size_t hstepA = (size_t)HALF * lda * 2, hstepB = (size_t)HALF * K * 2;
    const size_t tstepA = 2 * hstepA, tstepB = 2 * hstepB;
    const unsigned ldsw = (unsigned)wid * 1024u;
    const int aoff = lds_byte(wr * 64 + fr, fq * 8), boff = lds_byte(wc * 32 + fr, fq * 8);
#define PG8_SA(b, h) (((b) * 2 + (h)) * HTB)
#define PG8_SB(b, h) ((4 + (b) * 2 + (h)) * HTB)
#define PG8_STAGE(bufoff, gbase, voff) do { _Pragma("unroll") for (int _i = 0; _i < 2; ++_i) \
        __builtin_amdgcn_global_load_lds((const unsigned*)((const char*)(gbase) + (voff)[_i]), (LAS unsigned*)(lds + (bufoff) + ldsw + _i * 8192), 16, 0, 0); } while (0)
#define PG8_LDA(dst, b, h) do { _Pragma("unroll") for (int m = 0; m < 4; ++m) _Pragma("unroll") for (int k = 0; k < 2; ++k) dst[m][k] = *(const LAS bf16x8*)(lds + PG8_SA(b, h) + aoff + m * 2048 + k * 1024); } while (0)
#define PG8_LDB(dst, b, h) do { _Pragma("unroll") for (int n = 0; n < 2; ++n) _Pragma("unroll") for (int k = 0; k < 2; ++k) dst[n][k] = *(const LAS bf16x8*)(lds + PG8_SB(b, h) + boff + n * 2048 + k * 1024); } while (0)
#define PG8_MMA(ai, bj, At, Bt) do { __builtin_amdgcn_s_setprio(1); _Pragma("unroll") for (int m = 0; m < 4; ++m) _Pragma("unroll") for (int n = 0; n < 2; ++n) _Pragma("unroll") for (int k = 0; k < 2; ++k) \
        acc[ai][bj][m][n] = __builtin_amdgcn_mfma_f32_16x16x32_bf16(Bt[n][k], At[m][k], acc[ai][bj][m][n], 0, 0, 0); __builtin_amdgcn_s_setprio(0); } while (0)
#define PG8_WAIT_V(n) asm volatile("s_waitcnt vmcnt(" #n ")" ::: "memory")
#define PG8_WAIT_L(n) asm volatile("s_waitcnt lgkmcnt(" #n ")" ::: "memory")
#define PG8_BAR __builtin_amdgcn_s_barrier()
#define PG8_SCHED __builtin_amdgcn_sched_barrier(0)
    Unit cur, nxt; int ui = 0;
    if (!S.next(0, cur)) return;
    f32x4 acc[2][2][4][2];
#pragma unroll
    for (int a = 0; a < 2; ++a)
#pragma unroll
        for (int b = 0; b < 2; ++b)
#pragma unroll
            for (int m = 0; m < 4; ++m)
#pragma unroll
                for (int n = 0; n < 2; ++n) acc[a][b][m][n] = (f32x4){0.f, 0.f, 0.f, 0.f};
    bf16x8 At[4][2], B0[2][2], B1[2][2];
    const char* cA = (const char*)g.A + (size_t)cur.pm * tstepA; const char* cB = (const char*)g.Bt + (size_t)cur.pn * tstepB;
    PG8_STAGE(PG8_SB(0, 0), cB, voffB); PG8_STAGE(PG8_SA(0, 0), cA, voffA); PG8_STAGE(PG8_SB(0, 1), cB + hstepB, voffB); PG8_STAGE(PG8_SA(0, 1), cA + hstepA, voffA);
    if (wr == 1) PG8_BAR;
    PG8_WAIT_V(4); PG8_BAR;
    PG8_STAGE(PG8_SB(1, 0), cB + kstep, voffB); PG8_STAGE(PG8_SA(1, 0), cA + kstep, voffA); PG8_STAGE(PG8_SB(1, 1), cB + hstepB + kstep, voffB);
    PG8_WAIT_V(6); PG8_BAR;
    for (;;) {
        const bool has_next = S.next(ui + 1, nxt);
        const char* nA = has_next ? (const char*)g.A + (size_t)nxt.pm * tstepA : cA; const char* nB = has_next ? (const char*)g.Bt + (size_t)nxt.pn * tstepB : cB;
        for (int t = 0; t < nt; t += 2) {
            const bool last = (t == nt - 2);
            const char* a1 = cA + (size_t)(t + 1) * kstep;
            const char* a2 = last ? nA : cA + (size_t)(t + 2) * kstep; const char* b2 = last ? nB : cB + (size_t)(t + 2) * kstep;
            const char* a3 = a2 + kstep; const char* b3 = b2 + kstep;
            PG8_LDB(B0, 0, 0); PG8_SCHED; PG8_LDA(At, 0, 0); PG8_STAGE(PG8_SA(1, 1), a1 + hstepA, voffA);
            PG8_WAIT_L(8); PG8_BAR; PG8_WAIT_L(0); PG8_MMA(0, 0, At, B0); PG8_BAR; PG8_SCHED;
            PG8_LDB(B1, 0, 1); PG8_STAGE(PG8_SB(0, 0), b2, voffB);
            PG8_BAR; PG8_WAIT_L(0); PG8_MMA(0, 1, At, B1); PG8_BAR;
            PG8_LDA(At, 0, 1); PG8_STAGE(PG8_SA(0, 0), a2, voffA);
            PG8_BAR; PG8_WAIT_L(0); PG8_MMA(1, 0, At, B0); PG8_BAR; PG8_SCHED;
            PG8_STAGE(PG8_SB(0, 1), b2 + hstepB, voffB);
            PG8_WAIT_V(6); PG8_BAR; PG8_MMA(1, 1, At, B1); PG8_BAR;
            PG8_LDB(B0, 1, 0); PG8_SCHED; PG8_LDA(At, 1, 0); PG8_STAGE(PG8_SA(0, 1), a2 + hstepA, voffA);
            PG8_WAIT_L(8); PG8_BAR; PG8_WAIT_L(0); PG8_MMA(0, 0, At, B0); PG8_BAR; PG8_SCHED;
            PG8_LDB(B1, 1, 1); PG8_STAGE(PG8_SB(1, 0), b3, voffB);
            PG8_BAR; PG8_WAIT_L(0); PG8_MMA(0, 1, At, B1); PG8_BAR;
            PG8_LDA(At, 1, 1); PG8_STAGE(PG8_SA(1, 0), a3, voffA);
            PG8_BAR; PG8_WAIT_L(0); PG8_MMA(1, 0, At, B0); PG8_BAR; PG8_SCHED;
            PG8_STAGE(PG8_SB(1, 1), b3 + hstepB, voffB);
            PG8_WAIT_V(6); PG8_BAR; PG8_MMA(1, 1, At, B1); PG8_BAR;
        }
        E(acc, cur, wr, wc, fr, fq);
        if (!has_next) break;
#pragma unroll
        for (int a = 0; a < 2; ++a)
#pragma unroll
            for (int b = 0; b < 2; ++b)
#pragma unroll
                for (int m = 0; m < 4; ++m)
#pragma unroll
                    for (int n = 0; n < 2; ++n) acc[a][b][m][n] = (f32x4){0.f, 0.f, 0.f, 0.f};
        cur = nxt; cA = nA; cB = nB; ++ui;
    }
    PG8_WAIT_V(0);
    if (wr == 0) PG8_BAR;
    PG8_BAR;
#undef PG8_SA
#undef PG8_SB
#undef PG8_STAGE
#undef PG8_LDA
#undef PG8_LDB
#undef PG8_MMA
#undef PG8_WAIT_V
#undef PG8_WAIT_L
#undef PG8_BAR
#undef PG8_SCHED
}
}

typedef f32x4 AccT[2][2][4][2];

struct EpiG1 {
    static constexpr bool PERM = true;
    bf16_t* P; const float* rstd1;
    __device__ __forceinline__ void operator()(const AccT& acc, const pg8::Unit& u, int wr, int wc, int fr, int fq) const {
        const int row0 = u.pm * 256 + wr * 64 + fr, col0 = u.pn * 256 + wc * 32 + 8 * fq;
        const int pn = u.pn; const int mode = (pn >= 24) ? 2 : ((pn >= 4 && pn < 8) || (pn >= 20)) ? 1 : 0;
#pragma unroll
        for (int ai = 0; ai < 2; ++ai)
#pragma unroll
            for (int m = 0; m < 4; ++m) { const int row = row0 + ai * 128 + m * 16; bf16_t* rowp = P + (size_t)row * INW + col0;
#pragma unroll
                for (int bj = 0; bj < 2; ++bj) { float v[8];
#pragma unroll
                    for (int j = 0; j < 4; ++j) { v[j] = acc[ai][bj][m][0][j]; v[4 + j] = acc[ai][bj][m][1][j]; }
                    if (mode == 1) {
#pragma unroll
                        for (int j = 0; j < 8; ++j) v[j] = siluf_(v[j]); }
                    else if (mode == 2) {
#pragma unroll
                        for (int j = 0; j < 8; ++j) v[j] = sigmoidf_(v[j]); }
                    u32x4 w; w.x = cvt_pk_bf16(v[0], v[1]); w.y = cvt_pk_bf16(v[2], v[3]); w.z = cvt_pk_bf16(v[4], v[5]); w.w = cvt_pk_bf16(v[6], v[7]);
                    *(u32x4*)(rowp + bj * 128) = w; } }
    }
};
struct EpiD1 {
    static constexpr bool PERM = true;
    const bf16_t* P; const float* glu_b; bf16_t* Y2;
    __device__ __forceinline__ void operator()(const AccT& acc, const pg8::Unit& u, int wr, int wc, int fr, int fq) const {
        const int row0 = u.pm * 256 + wr * 64 + fr, col0 = u.pn * 256 + wc * 32 + 8 * fq;
        u32x4 pk[2][4][2];
#pragma unroll
        for (int ai = 0; ai < 2; ++ai)
#pragma unroll
            for (int m = 0; m < 4; ++m)
#pragma unroll
                for (int bj = 0; bj < 2; ++bj) { const f32x4 a0 = acc[ai][bj][m][0], a1 = acc[ai][bj][m][1];
                    pk[ai][m][bj].x = cvt_pk_bf16(a0[0], a0[1]); pk[ai][m][bj].y = cvt_pk_bf16(a0[2], a0[3]); pk[ai][m][bj].z = cvt_pk_bf16(a1[0], a1[1]); pk[ai][m][bj].w = cvt_pk_bf16(a1[2], a1[3]); }
        f32x4 b0[2], b1[2];
#pragma unroll
        for (int bj = 0; bj < 2; ++bj) { b0[bj] = *(const f32x4*)(glu_b + col0 + bj * 128); b1[bj] = *(const f32x4*)(glu_b + col0 + bj * 128 + 4); }
        u32x4 yg[2][4][2], sz[2][4][2];
#pragma unroll
        for (int ai = 0; ai < 2; ++ai)
#pragma unroll
            for (int m = 0; m < 4; ++m)
#pragma unroll
                for (int bj = 0; bj < 2; ++bj) { const bf16_t* pr = P + (size_t)(row0 + ai * 128 + m * 16) * INW + col0 + bj * 128;
                    yg[ai][m][bj] = *(const u32x4*)(pr + COL_SX); sz[ai][m][bj] = *(const u32x4*)(pr + COL_SZ); }
#pragma unroll
        for (int ai = 0; ai < 2; ++ai)
#pragma unroll
            for (int m = 0; m < 4; ++m)
#pragma unroll
                for (int bj = 0; bj < 2; ++bj) { const int row = row0 + ai * 128 + m * 16, col = col0 + bj * 128; const u32x4 q = pk[ai][m][bj], g = yg[ai][m][bj], z = sz[ai][m][bj];
                    const f32x4 t0 = (f32x4){bf_lo(q.x), bf_hi(q.x), bf_lo(q.y), bf_hi(q.y)} + b0[bj], t1 = (f32x4){bf_lo(q.z), bf_hi(q.z), bf_lo(q.w), bf_hi(q.w)} + b1[bj]; float v[8];
                    v[0] = bf_lo(g.x) * sigmoidf_(t0[0]) * bf_lo(z.x); v[1] = bf_hi(g.x) * sigmoidf_(t0[1]) * bf_hi(z.x);
                    v[2] = bf_lo(g.y) * sigmoidf_(t0[2]) * bf_lo(z.y); v[3] = bf_hi(g.y) * sigmoidf_(t0[3]) * bf_hi(z.y);
                    v[4] = bf_lo(g.z) * sigmoidf_(t1[0]) * bf_lo(z.z); v[5] = bf_hi(g.z) * sigmoidf_(t1[1]) * bf_hi(z.z);
                    v[6] = bf_lo(g.w) * sigmoidf_(t1[2]) * bf_lo(z.w); v[7] = bf_hi(g.w) * sigmoidf_(t1[3]) * bf_hi(z.w);
                    u32x4 w; w.x = cvt_pk_bf16(v[0], v[1]); w.y = cvt_pk_bf16(v[2], v[3]); w.z = cvt_pk_bf16(v[4], v[5]); w.w = cvt_pk_bf16(v[6], v[7]);
                    *(u32x4*)(Y2 + (size_t)row * 1024 + col) = w; }
    }
};
template <int MODE> struct EpiGate {
    static constexpr bool PERM = true;
    bf16_t* P;
    __device__ __forceinline__ void operator()(const AccT& acc, const pg8::Unit& u, int wr, int wc, int fr, int fq) const {
        const int row0 = u.pm * 256 + wr * 64 + fr, col0 = u.pn * 256 + wc * 32 + 8 * fq;
        u32x4 pk[2][4][2], gs[2][4][2], ga[2][4][2];
        if (MODE == 1) {
#pragma unroll
            for (int ai = 0; ai < 2; ++ai)
#pragma unroll
                for (int m = 0; m < 4; ++m)
#pragma unroll
                    for (int bj = 0; bj < 2; ++bj) { const f32x4 a0 = acc[ai][bj][m][0], a1 = acc[ai][bj][m][1];
                        pk[ai][m][bj].x = cvt_pk_bf16(a0[0], a0[1]); pk[ai][m][bj].y = cvt_pk_bf16(a0[2], a0[3]); pk[ai][m][bj].z = cvt_pk_bf16(a1[0], a1[1]); pk[ai][m][bj].w = cvt_pk_bf16(a1[2], a1[3]); }
        }
        if (MODE != 2) {
#pragma unroll
            for (int ai = 0; ai < 2; ++ai)
#pragma unroll
                for (int m = 0; m < 4; ++m)
#pragma unroll
                    for (int bj = 0; bj < 2; ++bj) { const bf16_t* pr = P + (size_t)(row0 + ai * 128 + m * 16) * INW + col0 + bj * 128;
                        gs[ai][m][bj] = *(const u32x4*)(pr + COL_GS); if (MODE == 1) ga[ai][m][bj] = *(const u32x4*)(pr + COL_GA); }
        }
#pragma unroll
        for (int ai = 0; ai < 2; ++ai)
#pragma unroll
            for (int m = 0; m < 4; ++m)
#pragma unroll
                for (int bj = 0; bj < 2; ++bj) { bf16_t* pr = P + (size_t)(row0 + ai * 128 + m * 16) * INW + col0 + bj * 128; float v[8];
                    if (MODE == 2) { const f32x4 a0 = acc[ai][bj][m][0], a1 = acc[ai][bj][m][1]; v[0] = a0[0]; v[1] = a0[1]; v[2] = a0[2]; v[3] = a0[3]; v[4] = a1[0]; v[5] = a1[1]; v[6] = a1[2]; v[7] = a1[3]; }
                    else if (MODE == 0) { const f32x4 a0 = acc[ai][bj][m][0], a1 = acc[ai][bj][m][1]; const u32x4 g = gs[ai][m][bj];
                        v[0] = bf_lo(g.x) * a0[0]; v[1] = bf_hi(g.x) * a0[1]; v[2] = bf_lo(g.y) * a0[2]; v[3] = bf_hi(g.y) * a0[3];
                        v[4] = bf_lo(g.z) * a1[0]; v[5] = bf_hi(g.z) * a1[1]; v[6] = bf_lo(g.w) * a1[2]; v[7] = bf_hi(g.w) * a1[3]; }
                    else { const u32x4 g = gs[ai][m][bj], h = ga[ai][m][bj], q = pk[ai][m][bj];
                        v[0] = bf_lo(g.x) + bf_lo(h.x) * bf_lo(q.x); v[1] = bf_hi(g.x) + bf_hi(h.x) * bf_hi(q.x); v[2] = bf_lo(g.y) + bf_lo(h.y) * bf_lo(q.y); v[3] = bf_hi(g.y) + bf_hi(h.y) * bf_hi(q.y);
                        v[4] = bf_lo(g.z) + bf_lo(h.z) * bf_lo(q.z); v[5] = bf_hi(g.z) + bf_hi(h.z) * bf_hi(q.z); v[6] = bf_lo(g.w) + bf_lo(h.w) * bf_lo(q.w); v[7] = bf_hi(g.w) + bf_hi(h.w) * bf_hi(q.w); }
                    u32x4 w; w.x = cvt_pk_bf16(v[0], v[1]); w.y = cvt_pk_bf16(v[2], v[3]); w.z = cvt_pk_bf16(v[4], v[5]); w.w = cvt_pk_bf16(v[6], v[7]);
                    *(u32x4*)(pr + (MODE == 2 ? COL_PP : COL_GS)) = w; }
    }
};
struct EpiD3 {
    static constexpr bool PERM = false;
    const float* xp; const float* xs; bf16_t* P; float* ss2;
    __device__ __forceinline__ void operator()(const AccT& acc, const pg8::Unit& u, int wr, int wc, int fr, int fq) const {
        const int row0 = u.pm * 256 + wr * 64 + fr, col0 = u.pn * 256 + wc * 32 + 4 * fq;
        const float* xbase = (u.pm * 256 < T_P) ? xp : xs - (size_t)T_P * DM;
        u32x2 pk[2][4][2][2];
#pragma unroll
        for (int ai = 0; ai < 2; ++ai)
#pragma unroll
            for (int m = 0; m < 4; ++m)
#pragma unroll
                for (int bj = 0; bj < 2; ++bj)
#pragma unroll
                    for (int n = 0; n < 2; ++n) { const f32x4 a = acc[ai][bj][m][n]; pk[ai][m][bj][n].x = cvt_pk_bf16(a[0], a[1]); pk[ai][m][bj][n].y = cvt_pk_bf16(a[2], a[3]); }
        f32x4 xv[2][4][2][2];
#pragma unroll
        for (int ai = 0; ai < 2; ++ai)
#pragma unroll
            for (int m = 0; m < 4; ++m)
#pragma unroll
                for (int bj = 0; bj < 2; ++bj)
#pragma unroll
                    for (int n = 0; n < 2; ++n) xv[ai][m][bj][n] = *(const f32x4*)(xbase + (size_t)(row0 + ai * 128 + m * 16) * DM + col0 + bj * 128 + n * 16);
#pragma unroll
        for (int ai = 0; ai < 2; ++ai)
#pragma unroll
            for (int m = 0; m < 4; ++m) { const int row = row0 + ai * 128 + m * 16; float s = 0.f;
#pragma unroll
                for (int bj = 0; bj < 2; ++bj)
#pragma unroll
                    for (int n = 0; n < 2; ++n) { const int col = col0 + bj * 128 + n * 16; const u32x2 q = pk[ai][m][bj][n];
                        const f32x4 h = xv[ai][m][bj][n] + (f32x4){bf_lo(q.x), bf_hi(q.x), bf_lo(q.y), bf_hi(q.y)};
                        u32x2 w; w.x = cvt_pk_bf16(h[0], h[1]); w.y = cvt_pk_bf16(h[2], h[3]); *(u32x2*)(P + (size_t)row * INW + COL_HB + col) = w;
                        s += (h[0] * h[0] + h[1] * h[1]) + (h[2] * h[2] + h[3] * h[3]); }
                s += __shfl_xor(s, 16); s += __shfl_xor(s, 32);
                if (fq == 0) atomicAdd(ss2 + row, s); }
    }
};
struct EpiD4 {
    static constexpr bool PERM = false;
    bf16_t* P; const float* ss2; float* ss3;
    __device__ __forceinline__ void operator()(const AccT& acc, const pg8::Unit& u, int wr, int wc, int fr, int fq) const {
        const int row0 = u.pm * 256 + wr * 64 + fr, col0 = u.pn * 256 + wc * 32 + 4 * fq;
        u32x2 pk[2][4][2][2];
#pragma unroll
        for (int ai = 0; ai < 2; ++ai)
#pragma unroll
            for (int m = 0; m < 4; ++m)
#pragma unroll
                for (int bj = 0; bj < 2; ++bj)
#pragma unroll
                    for (int n = 0; n < 2; ++n) { const f32x4 a = acc[ai][bj][m][n]; pk[ai][m][bj][n].x = cvt_pk_bf16(a[0], a[1]); pk[ai][m][bj][n].y = cvt_pk_bf16(a[2], a[3]); }
        u32x2 hw[2][4][2][2], pw[2][4][2][2]; float rsv[2][4];
#pragma unroll
        for (int ai = 0; ai < 2; ++ai)
#pragma unroll
            for (int m = 0; m < 4; ++m) { rsv[ai][m] = ss2[row0 + ai * 128 + m * 16];
#pragma unroll
                for (int bj = 0; bj < 2; ++bj)
#pragma unroll
                    for (int n = 0; n < 2; ++n) { const bf16_t* pr = P + (size_t)(row0 + ai * 128 + m * 16) * INW + col0 + bj * 128 + n * 16;
                        hw[ai][m][bj][n] = *(const u32x2*)(pr + COL_HB); pw[ai][m][bj][n] = *(const u32x2*)(pr + COL_PP); } }
#pragma unroll
        for (int ai = 0; ai < 2; ++ai)
#pragma unroll
            for (int m = 0; m < 4; ++m) { const int row = row0 + ai * 128 + m * 16; float s = 0.f; const float r = __builtin_amdgcn_rsqf(rsv[ai][m] * (1.0f / DM) + EPS);
#pragma unroll
                for (int bj = 0; bj < 2; ++bj)
#pragma unroll
                    for (int n = 0; n < 2; ++n) { const int col = col0 + bj * 128 + n * 16; bf16_t* pr = P + (size_t)row * INW + col;
                        const u32x2 hq = hw[ai][m][bj][n], pq = pw[ai][m][bj][n], q = pk[ai][m][bj][n]; f32x4 h;
                        h[0] = bf_lo(hq.x) + sigmoidf_(bf_lo(q.x) * r) * bf_lo(pq.x); h[1] = bf_hi(hq.x) + sigmoidf_(bf_hi(q.x) * r) * bf_hi(pq.x);
                        h[2] = bf_lo(hq.y) + sigmoidf_(bf_lo(q.y) * r) * bf_lo(pq.y); h[3] = bf_hi(hq.y) + sigmoidf_(bf_hi(q.y) * r) * bf_hi(pq.y);
                        u32x2 w; w.x = cvt_pk_bf16(h[0], h[1]); w.y = cvt_pk_bf16(h[2], h[3]); *(u32x2*)(pr + COL_H2) = w;
                        s += (h[0] * h[0] + h[1] * h[1]) + (h[2] * h[2] + h[3] * h[3]); }
                s += __shfl_xor(s, 16); s += __shfl_xor(s, 32);
                if (fq == 0) atomicAdd(ss3 + row, s); }
    }
};

namespace att {
constexpr int D = 128, DV = 256, NW = 8, QBLK = 32, KVBLK = 32;
constexpr float SCALE = 0.088388347648318440f;
constexpr float THR2 = 8.f * LOG2E;
constexpr int LDQ = INW, LDK = INW, LDO = 1024;
constexpr int SHM_V = KVBLK * DV * 2, SHM_K = KVBLK * D * 2;
constexpr int OFF_V = 0, OFF_K = 2 * SHM_V, OFF_Q = OFF_K + 2 * SHM_K, OFF_W = OFF_Q + NW * QBLK * D * 2, OFF_TAB = OFF_W + NW * 64 * 4, SHM_ATTN = OFF_TAB + 384 * 4;
static_assert(SHM_ATTN <= 131072, "attention LDS");
#define KSWZ(row, colB) ((row) * 256 + ((colB) ^ (((row) & 7) << 4)))
#define SBAR() __builtin_amdgcn_sched_barrier(0)
__device__ __forceinline__ int crow(int r, int hi) { return (r & 3) + 8 * (r >> 2) + 4 * hi; }

struct BiasCtx { const LAS float* tab; float cL, cR; int qlo, qrow, hi; };
__device__ __forceinline__ void add_bias(f32x16& p0, int k0, const BiasCtx& B) {
    constexpr float C = SCALE * LOG2E;
    if (k0 + 31 - B.qlo <= -91) {
#pragma unroll
        for (int r = 0; r < 16; ++r) p0[r] = fmaf(p0[r], C, B.cL);
    } else if (k0 - (B.qlo + 31) >= 91) {
#pragma unroll
        for (int r = 0; r < 16; ++r) p0[r] = fmaf(p0[r], C, B.cR);
    } else {
        const LAS float* tb = B.tab + (k0 - B.qrow + 192 + 4 * B.hi);
#pragma unroll
        for (int r = 0; r < 16; ++r) p0[r] = fmaf(p0[r], C, tb[(r & 3) + 8 * (r >> 2)]);
    }
}
__device__ __forceinline__ void softmax_tile(f32x16& p0, float& m_reg, float& l_reg, float& alpha, int k0, const BiasCtx& B, bf16x8& pa0, bf16x8& pa1) {
    constexpr float C = SCALE * LOG2E;
    const bool farL = (k0 + 31 - B.qlo <= -91), farR = (k0 - (B.qlo + 31) >= 91);
    float mn;
    if (farL || farR) {
        const float cb = farL ? B.cL : B.cR;
        float pmax = p0[0];
#pragma unroll
        for (int r = 1; r < 16; ++r) pmax = fmaxf(pmax, p0[r]);
        { auto rr = __builtin_amdgcn_permlane32_swap(__float_as_uint(pmax), __float_as_uint(pmax), false, false);
          pmax = fmaxf(__uint_as_float(rr[0]), __uint_as_float(rr[1])); }
        pmax = fmaf(pmax, C, cb);
        if (__builtin_expect(__all(pmax - m_reg <= THR2), 1)) { mn = m_reg; alpha = 1.f; }
        else { mn = fmaxf(m_reg, pmax); alpha = __builtin_amdgcn_exp2f(m_reg - mn); m_reg = mn; }
        const float off = cb - mn;
#pragma unroll
        for (int r = 0; r < 16; ++r) p0[r] = __builtin_amdgcn_exp2f(fmaf(p0[r], C, off));
    } else {
        add_bias(p0, k0, B);
        float pmax = p0[0];
#pragma unroll
        for (int r = 1; r < 16; ++r) pmax = fmaxf(pmax, p0[r]);
        { auto rr = __builtin_amdgcn_permlane32_swap(__float_as_uint(pmax), __float_as_uint(pmax), false, false);
          pmax = fmaxf(__uint_as_float(rr[0]), __uint_as_float(rr[1])); }
        if (__builtin_expect(__all(pmax - m_reg <= THR2), 1)) { mn = m_reg; alpha = 1.f; }
        else { mn = fmaxf(m_reg, pmax); alpha = __builtin_amdgcn_exp2f(m_reg - mn); m_reg = mn; }
#pragma unroll
        for (int r = 0; r < 16; ++r) p0[r] = __builtin_amdgcn_exp2f(p0[r] - mn);
    }
    float ps = 0;
#pragma unroll
    for (int r = 0; r < 16; ++r) ps += p0[r];
    { auto rr = __builtin_amdgcn_permlane32_swap(__float_as_uint(ps), __float_as_uint(ps), false, false);
      ps = __uint_as_float(rr[0]) + __uint_as_float(rr[1]); }
    l_reg = l_reg * alpha + ps;
#define PK4(P, BASE, OUT) do { unsigned a0 = cvt_pk_bf16(P[BASE + 0], P[BASE + 1]), a1 = cvt_pk_bf16(P[BASE + 2], P[BASE + 3]);   \
    unsigned b0 = cvt_pk_bf16(P[BASE + 4], P[BASE + 5]), b1 = cvt_pk_bf16(P[BASE + 6], P[BASE + 7]);                              \
    auto r0 = __builtin_amdgcn_permlane32_swap(a0, b0, false, false); auto r1 = __builtin_amdgcn_permlane32_swap(a1, b1, false, false); \
    u32x4 w = {r0[0], r1[0], r0[1], r1[1]}; OUT = *reinterpret_cast<bf16x8*>(&w); } while (0)
    PK4(p0, 0, pa0); PK4(p0, 8, pa1);
#undef PK4
}
__device__ __forceinline__ void qkt(f32x16& p0, const char* Ks, const bf16x8* qr, const int* ko) {
    p0 = f32x16{};
#define KFR(d0) (*reinterpret_cast<const bf16x8*>(Ks + ko[(d0) & 3] + ((d0) >> 2) * 128))
    bf16x8 k0 = KFR(0), k1 = KFR(1);
#pragma unroll
    for (int g = 0; g < 4; ++g) {
        bf16x8 nk0 = k0, nk1 = k1;
        if (g < 3) { nk0 = KFR(2 * g + 2); nk1 = KFR(2 * g + 3); }
        SBAR();
        p0 = __builtin_amdgcn_mfma_f32_32x32x16_bf16(k0, qr[2 * g], p0, 0, 0, 0);
        p0 = __builtin_amdgcn_mfma_f32_32x32x16_bf16(k1, qr[2 * g + 1], p0, 0, 0, 0);
        SBAR();
        k0 = nk0; k1 = nk1;
    }
#undef KFR
}
__device__ __forceinline__ int v_st(int k, int c) { const int kk = (k & ~0xC) | ((k & 4) << 1) | ((k & 8) >> 1); return ((kk >> 3) * 8 + (c >> 5)) * 512 + ((kk & 7) * 32 + (c & 31)) * 2; }
__device__ __forceinline__ int v_rd_base(int lane) { return ((lane & 3) << 3) | (((lane >> 2) & 3) << 6) | (((lane >> 4) & 1) << 5) | (((lane >> 5) & 1) << 8); }
constexpr int v_rd_off(int d0, int ks, int half) { return d0 * 512 + ks * 8192 + half * 4096; }
template <int OFF> __device__ __forceinline__ s16x4 tr_read(int vb) {
    s16x4 r; asm volatile("ds_read_b64_tr_b16 %0, %1 offset:%2" : "=&v"(r) : "v"(vb), "i"(OFF) : "memory"); return r;
}
struct VFrag { s16x4 l0, h0, l1, h1; };
template <int D0> __device__ __forceinline__ VFrag v_read(int vb) {
    VFrag f; f.l0 = tr_read<v_rd_off(D0, 0, 0)>(vb); f.h0 = tr_read<v_rd_off(D0, 0, 1)>(vb); f.l1 = tr_read<v_rd_off(D0, 1, 0)>(vb); f.h1 = tr_read<v_rd_off(D0, 1, 1)>(vb); return f;
}
#define PK(L, H) (bf16x8){L[0], L[1], L[2], L[3], H[0], H[1], H[2], H[3]}
#define PV_STEP(D0, CUR, NXT, WAITN) do { if ((D0) < 7) NXT = v_read<((D0) < 7 ? (D0) + 1 : 7)>(vb); \
    asm volatile("s_waitcnt lgkmcnt(" #WAITN ")" ::: "memory"); SBAR(); \
    o[D0] = __builtin_amdgcn_mfma_f32_32x32x16_bf16(pa0, PK(CUR.l0, CUR.h0), o[D0], 0, 0, 0); \
    o[D0] = __builtin_amdgcn_mfma_f32_32x32x16_bf16(pa1, PK(CUR.l1, CUR.h1), o[D0], 0, 0, 0); SBAR(); } while (0)
__device__ __forceinline__ void pv_all(f32x16* o, int vb, bf16x8 pa0, bf16x8 pa1) {
    asm volatile("s_waitcnt lgkmcnt(0)" ::: "memory");
    VFrag fa = v_read<0>(vb), fb;
    PV_STEP(0, fa, fb, 4); PV_STEP(1, fb, fa, 4); PV_STEP(2, fa, fb, 4); PV_STEP(3, fb, fa, 4);
    PV_STEP(4, fa, fb, 4); PV_STEP(5, fb, fa, 4); PV_STEP(6, fa, fb, 4); PV_STEP(7, fb, fa, 0);
}
#undef PV_STEP
#undef PK

__device__ __forceinline__ void attn_pass(const bf16_t* __restrict__ Qb, const bf16_t* __restrict__ Kh, const bf16_t* __restrict__ Vh,
                                          float* Ob, int seq, char* lds, int mode, float lam, const LAS float* tab, float cL, float cR, int q0) {
    const int tid0 = threadIdx.x, wid = __builtin_amdgcn_readfirstlane(tid0 >> 6);
    char* V_lds = lds + OFF_V; char* K_lds = lds + OFF_K;
    float* wsl = (float*)(lds + OFF_W) + wid * 64; float* li_l = wsl; float* al_l = wsl + 32;
    float m_reg = -1e30f, l_reg = 0; f32x16 o[8] = {};
    struct Stg { bf16x8 vs0, vs1, ks0; } stA, stB;
#define SLOADX(ST, k0) do { const int sr = tq >> 4, sc = (tq & 15) * 8; const bf16_t* vp = Vh + (long)((k0) + sr) * LDK + sc; const bf16_t* kp = Kh + (long)((k0) + sr) * LDK + sc; \
    ST.vs0 = *reinterpret_cast<const bf16x8*>(vp); ST.vs1 = *reinterpret_cast<const bf16x8*>(vp + 128); ST.ks0 = *reinterpret_cast<const bf16x8*>(kp); } while (0)
#define SWRITEX(ST, b) do { const int sr = tq >> 4, sc = (tq & 15) * 8; \
    *(bf16x8*)(V_lds + (b) * SHM_V + v_st(sr, sc)) = ST.vs0; *(bf16x8*)(V_lds + (b) * SHM_V + v_st(sr, sc + 128)) = ST.vs1; \
    *(bf16x8*)(K_lds + (b) * SHM_K + KSWZ(sr, sc * 2)) = ST.ks0; } while (0)
    const int NT = seq / KVBLK;
    bf16x8 qr[8];
    { int tq = tid0; asm volatile("" : "+v"(tq)); SLOADX(stA, 0); SLOADX(stB, KVBLK);
      const int lane = tq & 63, r32 = lane & 31, hi = lane >> 5;
      const bf16_t* Qw = Qb + (long)(wid * QBLK + r32) * LDQ + hi * 8;
#pragma unroll
      for (int d0 = 0; d0 < 8; ++d0) qr[d0] = *reinterpret_cast<const bf16x8*>(Qw + d0 * 16);
      SWRITEX(stA, 0); SWRITEX(stB, 1); if (2 < NT) SLOADX(stA, 2 * KVBLK); }
    asm volatile("" :: "v"(qr[0]), "v"(qr[1]), "v"(qr[2]), "v"(qr[3]), "v"(qr[4]), "v"(qr[5]), "v"(qr[6]), "v"(qr[7]));
    __syncthreads();
    int ko[4];
    { int tq = tid0; asm volatile("" : "+v"(tq)); const int lane = tq & 63, r32 = lane & 31, hi = lane >> 5, rsw = (r32 & 7) << 4;
#pragma unroll
      for (int i = 0; i < 4; ++i) ko[i] = r32 * 256 + ((((i * 16 + hi * 8) * 2)) ^ rsw);
    }
#define TILE_BODY(J, STW, STL) do { \
        int tq = tid0; asm volatile("" : "+v"(tq)); \
        const int lane = tq & 63, r32 = lane & 31, hi = lane >> 5; \
        const int b = (J) & 1; \
        f32x16 p0; float alpha; bf16x8 pa0, pa1; \
        SLOADX(STL, (((J) + 3 < NT) ? (J) + 3 : NT - 1) * KVBLK);     \
        qkt(p0, K_lds + b * SHM_K, qr, ko); \
        BiasCtx B; B.tab = tab; B.cL = cL; B.cR = cR; B.qlo = q0 + wid * QBLK; B.qrow = B.qlo + r32; B.hi = hi; \
        softmax_tile(p0, m_reg, l_reg, alpha, (J) * KVBLK, B, pa0, pa1); \
        if (__any(alpha < 1.f)) { if (hi == 0) al_l[r32] = alpha; asm volatile("s_waitcnt lgkmcnt(0)" ::: "memory"); \
            _Pragma("unroll") for (int r = 0; r < 16; ++r) { const float av = al_l[crow(r, hi)]; \
                _Pragma("unroll") for (int d = 0; d < 8; ++d) o[d][r] *= av; } } \
        pv_all(o, (int)(uintptr_t)V_lds + b * SHM_V + v_rd_base(lane), pa0, pa1); \
        asm volatile("s_waitcnt lgkmcnt(0)" ::: "memory"); __builtin_amdgcn_s_barrier(); asm volatile("" ::: "memory");     \
        SWRITEX(STW, b); } while (0)
#pragma unroll 1
    for (int j = 0; j < NT; j += 2) { TILE_BODY(j, stA, stB); TILE_BODY(j + 1, stB, stA); }
#undef TILE_BODY
    {
        int tq = tid0; asm volatile("" : "+v"(tq));
        const int lane = tq & 63, r32 = lane & 31, hi = lane >> 5;
        if (hi == 0) li_l[r32] = l_reg; asm volatile("s_waitcnt lgkmcnt(0)" ::: "memory");
        float* Ow = Ob + (long)(wid * QBLK + 4 * hi) * LDO + r32;
        if (mode == 0) {
#pragma unroll
            for (int r = 0; r < 16; ++r) { float* a = Ow + ((r & 3) + 8 * (r >> 2)) * LDO; const float rl = __builtin_amdgcn_rcpf(li_l[crow(r, hi)]);
#pragma unroll
                for (int d0 = 0; d0 < 8; ++d0) a[d0 * 32] = o[d0][r] * rl;
                SBAR(); }
        } else {
#pragma unroll
            for (int rg = 0; rg < 2; ++rg) {
                float prev[8][8];
#pragma unroll
                for (int rr = 0; rr < 8; ++rr) { const float* a = Ow + ((rr & 3) + 8 * (2 * rg + (rr >> 2))) * LDO;
#pragma unroll
                    for (int d0 = 0; d0 < 8; ++d0) prev[rr][d0] = a[d0 * 32]; }
#pragma unroll
                for (int rr = 0; rr < 8; ++rr) { const int r = 8 * rg + rr; float* a = Ow + ((rr & 3) + 8 * (2 * rg + (rr >> 2))) * LDO; const float rl = __builtin_amdgcn_rcpf(li_l[crow(r, hi)]);
#pragma unroll
                    for (int d0 = 0; d0 < 8; ++d0) a[d0 * 32] = prev[rr][d0] - lam * (o[d0][r] * rl); }
                SBAR(); }
        }
    }
#undef SLOADX
#undef SWRITEX
}
}

constexpr int SC_BROW = 528;
constexpr int SC_CHAIN_LDS = 16 * SC_BROW;
constexpr int SC_WAVE_LDS = 2 * SC_CHAIN_LDS;
__device__ __forceinline__ void scan_wave(const Params& p, char* ldsw, int tok0, int L, int g, int lane) {
    bf16_t* P = (bf16_t*)(p.ws + WS_P);
    float* YF = (float*)((char*)p.out + DO_YF);
    asm volatile("" : "+v"(lane));
    const int fr = lane & 15, fq = lane >> 4, n = lane;
    const float dsk = p.in[14][g * 16 + fr];
    float ar[2], ai[2]; bf16x8 af[2][8], cf[2][4];
#pragma unroll
    for (int dir = 0; dir < 2; ++dir) {
        const int dg = dir * 64 + g;
        const float lre = p.in[7][dg * 64 + n], lim = p.in[8][dg * 64 + n], dt = expf(p.in[9][dg]);
        const float mag = expf(lre * dt); ar[dir] = mag * cosf(lim * dt); ai[dir] = mag * sinf(lim * dt);
        const float den = lre * lre + lim * lim, nr = ar[dir] - 1.0f, ni = ai[dir];
        const float kre = (nr * lre + ni * lim) / den, kim = (ni * lre - nr * lim) / den;
#pragma unroll
        for (int q = 0; q < 8; ++q) {
            const int nq = 8 * q + (fr >> 1); const float kr = __shfl(kre, nq), ki = __shfl(kim, nq);
            u32x4 w = {0u, 0u, 0u, 0u};
            if (fq < 2) {
                const float* br = p.in[10] + ((size_t)dg * 64 + nq) * 16 + 8 * fq; const float* bi = p.in[11] + ((size_t)dg * 64 + nq) * 16 + 8 * fq;
                const f32x4 r0 = *(const f32x4*)br, r1 = *(const f32x4*)(br + 4), i0 = *(const f32x4*)bi, i1 = *(const f32x4*)(bi + 4);
                f32x4 v0, v1;
                if (fr & 1) { v0 = kr * i0 + ki * r0; v1 = kr * i1 + ki * r1; } else { v0 = kr * r0 - ki * i0; v1 = kr * r1 - ki * i1; }
                w.x = cvt_pk_bf16(v0[0], v0[1]); w.y = cvt_pk_bf16(v0[2], v0[3]); w.z = cvt_pk_bf16(v1[0], v1[1]); w.w = cvt_pk_bf16(v1[2], v1[3]);
            }
            af[dir][q] = *reinterpret_cast<bf16x8*>(&w);
        }
        const float* cre = p.in[12] + ((size_t)dg * 16 + fr) * 64; const float* cim = p.in[13] + ((size_t)dg * 16 + fr) * 64;
#pragma unroll
        for (int s = 0; s < 4; ++s) { u32x4 w; unsigned ww[4];
#pragma unroll
            for (int jj = 0; jj < 4; ++jj) { const int nn = 16 * s + 4 * fq + jj; ww[jj] = cvt_pk_bf16(cre[nn], -cim[nn]); }
            w.x = ww[0]; w.y = ww[1]; w.z = ww[2]; w.w = ww[3]; cf[dir][s] = *reinterpret_cast<bf16x8*>(&w); }
    }
    float hr[2] = {0.f, 0.f}, hi_[2] = {0.f, 0.f};
    const int nblk = L / 16, half = nblk / 2;
    const bf16_t* ubase = P + (size_t)(tok0 + fr) * INW + COL_SX + g * 16 + 8 * (fq & 1);
    u32x4 ureg[2] = {{0u, 0u, 0u, 0u}, {0u, 0u, 0u, 0u}};
    if (fq < 2) { ureg[0] = *(const u32x4*)(ubase); ureg[1] = *(const u32x4*)(ubase + (size_t)((nblk - 1) * 16) * INW); }
    for (int i = 0; i < nblk; ++i) {
        const int blk[2] = {i, nblk - 1 - i}; const bool second = (i >= half), hasn = (i + 1 < nblk);
        bf16x8 uf[2]; uf[0] = *reinterpret_cast<bf16x8*>(&ureg[0]); uf[1] = *reinterpret_cast<bf16x8*>(&ureg[1]);
        if (hasn && fq < 2) { ureg[0] = *(const u32x4*)(ubase + (size_t)((i + 1) * 16) * INW); ureg[1] = *(const u32x4*)(ubase + (size_t)((nblk - 2 - i) * 16) * INW); }
        f32x4 acc[2]; size_t orow[2];
#pragma unroll
        for (int d = 0; d < 2; ++d) { acc[d] = (f32x4){0.f, 0.f, 0.f, 0.f}; orow[d] = (size_t)(tok0 + blk[d] * 16 + fq * 4);
            if (second) {
#pragma unroll
                for (int j = 0; j < 4; ++j) acc[d][j] = YF[(orow[d] + j) * 1024 + g * 16 + fr] + dsk * __uint_as_float((unsigned)P[(orow[d] + j) * INW + COL_SX + g * 16 + fr] << 16);
            } }
#pragma unroll
        for (int d = 0; d < 2; ++d)
#pragma unroll
            for (int q = 0; q < 8; ++q) {
                const f32x4 dd = __builtin_amdgcn_mfma_f32_16x16x32_bf16(af[d][q], uf[d], (f32x4){0.f, 0.f, 0.f, 0.f}, 0, 0, 0);
                *(f32x4*)(ldsw + d * SC_CHAIN_LDS + fr * SC_BROW + (16 * q + 4 * fq) * 4) = dd;
            }
        __builtin_amdgcn_wave_barrier(); asm volatile("s_waitcnt lgkmcnt(0)" ::: "memory");
#pragma unroll 4
        for (int s = 0; s < 16; ++s) {
            char* r0 = ldsw + s * SC_BROW; char* r1 = ldsw + SC_CHAIN_LDS + (15 - s) * SC_BROW;
            const f32x2 b0 = *(const f32x2*)(r0 + n * 8), b1 = *(const f32x2*)(r1 + n * 8);
            const float f_r = fmaf(ar[0], hr[0], fmaf(-ai[0], hi_[0], b0[0])), f_i = fmaf(ar[0], hi_[0], fmaf(ai[0], hr[0], b0[1]));
            const float g_r = fmaf(ar[1], hr[1], fmaf(-ai[1], hi_[1], b1[0])), g_i = fmaf(ar[1], hi_[1], fmaf(ai[1], hr[1], b1[1]));
            hr[0] = f_r; hi_[0] = f_i; hr[1] = g_r; hi_[1] = g_i;
            *(unsigned*)(r0 + n * 4) = cvt_pk_bf16(f_r, f_i);
            *(unsigned*)(r1 + n * 4) = cvt_pk_bf16(g_r, g_i);
        }
        __builtin_amdgcn_wave_barrier(); asm volatile("s_waitcnt lgkmcnt(0)" ::: "memory");
#pragma unroll
        for (int s = 0; s < 4; ++s)
#pragma unroll
            for (int d = 0; d < 2; ++d) { const bf16x8 a = *(const bf16x8*)(ldsw + d * SC_CHAIN_LDS + fr * SC_BROW + (32 * s + 8 * fq) * 2);
                acc[d] = __builtin_amdgcn_mfma_f32_16x16x32_bf16(a, cf[d][s], acc[d], 0, 0, 0); }
#pragma unroll
        for (int d = 0; d < 2; ++d) {
            if (!second) {
#pragma unroll
                for (int j = 0; j < 4; ++j) YF[(orow[d] + j) * 1024 + g * 16 + fr] = acc[d][j];
            } else {
#pragma unroll
                for (int j = 0; j < 4; ++j) P[(orow[d] + j) * INW + COL_SX + g * 16 + fr] = (bf16_t)(cvt_pk_bf16(gelu_tanh(acc[d][j]), 0.f) & 0xffffu);
            } }
        __builtin_amdgcn_wave_barrier(); asm volatile("" ::: "memory");
    }
}

static_assert(8 * SC_WAVE_LDS <= 147456, "scan LDS");
__device__ __forceinline__ void transpose_cvt(const float* __restrict__ W, int K, int N, const float* __restrict__ rs, bf16_t* __restrict__ dst, float* tile  , int wg, int nwg) {
    const int tid = threadIdx.x, nkt = K / 64, nnt = N / 64, ntile = nkt * nnt;
    const int lk = tid >> 3, lseg = (tid & 7) * 8;
    for (int t = wg; t < ntile; t += nwg) {
        const int kt = t / nnt, ntl = t % nnt, k0 = kt * 64, n0 = ntl * 64;
        const float* src = W + (size_t)(k0 + lk) * N + n0 + lseg;
        const f32x4 a = *(const f32x4*)src, b = *(const f32x4*)(src + 4);
        float* tr = tile + lk * 65 + lseg;
        tr[0] = a[0]; tr[1] = a[1]; tr[2] = a[2]; tr[3] = a[3]; tr[4] = b[0]; tr[5] = b[1]; tr[6] = b[2]; tr[7] = b[3];
        __syncthreads();
        float v[8];
#pragma unroll
        for (int j = 0; j < 8; ++j) { v[j] = tile[(lseg + j) * 65 + lk]; if (rs) v[j] *= rs[k0 + lseg + j]; }
        u32x4 w; w.x = cvt_pk_bf16(v[0], v[1]); w.y = cvt_pk_bf16(v[2], v[3]); w.z = cvt_pk_bf16(v[4], v[5]); w.w = cvt_pk_bf16(v[6], v[7]);
        *(u32x4*)(dst + (size_t)(n0 + lk) * K + k0 + lseg) = w;
        __syncthreads();
    }
}
__device__ __forceinline__ int rel_bucket_dev(int rel) {
    const int n = rel < 0 ? -rel : rel;
    const int large = 8 + (n >= 12) + (n >= 16) + (n >= 23) + (n >= 32) + (n >= 46) + (n >= 64) + (n >= 91);
    return (rel > 0 ? 16 : 0) + (n < 8 ? n : large);
}


#define XB_TMO      128
#define XB_XCNT(j)  (256  + 64 * (j))
#define XB_XSUB(j)  (1280 + 64 * (j))
#define XB_XGEN(j)  (2304 + 64 * (j))
#define XB_TOP      3328
#define XB_TOPGEN   3392
#define XCD_BAR_WORDS 3456
#define XB_SPIN_CAP (1u << 22)
__device__ __forceinline__ unsigned xb_ld(unsigned* p)              { return __hip_atomic_load(p, __ATOMIC_RELAXED, __HIP_MEMORY_SCOPE_AGENT); }
__device__ __forceinline__ unsigned xb_add(unsigned* p, unsigned v) { return __hip_atomic_fetch_add(p, v, __ATOMIC_RELAXED, __HIP_MEMORY_SCOPE_AGENT); }
__device__ __forceinline__ unsigned xb_xcc_id() { return (unsigned)__builtin_amdgcn_s_getreg((3 << 11) | 20) & 0xFu; }
#define XB_SPIN(cond, bar) do { unsigned _sp = 0; while (cond) { __builtin_amdgcn_s_sleep(1); \
    if ((++_sp & 255u) == 0u) { if (xb_ld(&(bar)[XB_TMO])) break; if (_sp > XB_SPIN_CAP) { atomicAdd(&(bar)[XB_TMO], 1u); break; } } } } while (0)
struct XcdBarrier { unsigned* bar; unsigned x; volatile LAS unsigned* st; };
__device__ __forceinline__ XcdBarrier xcd_barrier_post(unsigned* bar, volatile LAS unsigned* st) {
    XcdBarrier b; b.bar = bar; b.x = xb_xcc_id(); b.st = st;
    if (threadIdx.x == 0) (void)xb_add(&bar[XB_XCNT(b.x)], 1u);
    return b;
}
__device__ __forceinline__ void xcd_barrier_complete(unsigned* bar, unsigned x, unsigned& nloc, unsigned& nx) {
    const unsigned G = gridDim.x * gridDim.y * gridDim.z;
    unsigned sum, cnt, mine, sp = 0u;
    for (;;) {
        sum = 0u; cnt = 0u; mine = 0u;
#pragma unroll
        for (unsigned j = 0; j < 16; ++j) { const unsigned c = xb_ld(&bar[XB_XCNT(j)]); sum += c; cnt += (c > 0u) ? 1u : 0u; mine = (j == x) ? c : mine; }
        if (sum == G) break;
        __builtin_amdgcn_s_sleep(1);
        if ((++sp & 255u) == 0u) { if (xb_ld(&bar[XB_TMO])) break; if (sp > XB_SPIN_CAP) { atomicAdd(&bar[XB_TMO], 1u); break; } }
    }
    nloc = mine > 0u ? mine : 1u; nx = cnt > 0u ? cnt : 1u;
}
__device__ __forceinline__ void xcd_barrier(const XcdBarrier& b) {
    asm volatile("s_waitcnt vmcnt(0)" ::: "memory");
    __syncthreads();
    if (threadIdx.x == 0) {
        unsigned* bar = b.bar;
        __builtin_amdgcn_s_waitcnt(0);
        unsigned nloc = b.st[0], nx = b.st[1];
        if (nloc == 0u) { xcd_barrier_complete(bar, b.x, nloc, nx); b.st[0] = nloc; b.st[1] = nx; }
        const unsigned old = xb_add(&bar[XB_XSUB(b.x)], 1u);
        const unsigned gen = old / nloc;
        if (old + 1u == (gen + 1u) * nloc) {
            __builtin_amdgcn_fence(__ATOMIC_RELEASE, "agent");
            asm volatile("s_waitcnt vmcnt(0)" ::: "memory");
            const unsigned og = xb_add(&bar[XB_TOP], 1u);
            const unsigned tg = og / nx;
            if (og + 1u == (tg + 1u) * nx) xb_add(&bar[XB_TOPGEN], 1u);
            else XB_SPIN(xb_ld(&bar[XB_TOPGEN]) == tg, bar);
            __builtin_amdgcn_fence(__ATOMIC_ACQUIRE, "agent");
            xb_add(&bar[XB_XGEN(b.x)], 1u);
            asm volatile("s_waitcnt vmcnt(0)" ::: "memory");
        } else {
            XB_SPIN(xb_ld(&bar[XB_XGEN(b.x)]) == gen, bar);
            __builtin_amdgcn_fence(__ATOMIC_ACQUIRE, "agent");
            asm volatile("s_waitcnt vmcnt(0)" ::: "memory");
        }
    }
    __syncthreads();
}

#ifndef PH_0
#define PH_0 1
#define PH_1 1
#define PH_2 1
#define PH_3 1
#define PH_4 1
#define PH_5 1
#define PH_6 1
#endif
constexpr int LDS_MISC = 147456;
constexpr int LDS_BYTES = LDS_MISC + 64;
__global__ void __launch_bounds__(512, 2) hybrid_fwd(Params p) {
    extern __shared__ __attribute__((aligned(16))) unsigned char lds[];
    cg::grid_group grid = cg::this_grid();
    const int tid = threadIdx.x, lane = tid & 63, wid = __builtin_amdgcn_readfirstlane(tid >> 6);
    const int G = gridDim.x, bx = blockIdx.x;
    unsigned char* ws = p.ws;
    bf16_t* P = (bf16_t*)(ws + WS_P);
    bf16_t* XB = (bf16_t*)((char*)p.out + DO_XB); bf16_t* WIN = (bf16_t*)((char*)p.out + DO_WIN);
    bf16_t* Y2 = (bf16_t*)((char*)p.out + DO_Y2); float* OSC = (float*)((char*)p.out + DO_OSC);
    bf16_t* WGLU = (bf16_t*)(ws + WS_WGLU); bf16_t* WBS = (bf16_t*)(ws + WS_WBS); bf16_t* WBA = (bf16_t*)(ws + WS_WBA);
    bf16_t* WOUT = (bf16_t*)(ws + WS_WOUT); bf16_t* WPG = (bf16_t*)(ws + WS_WPG); bf16_t* WPP = (bf16_t*)(ws + WS_WPP);
    bf16_t* PB = (bf16_t*)(ws + WS_PB);
    float* rstd1 = (float*)(ws + WS_RSTD1); float* ss2 = (float*)(ws + WS_SS2); float* ss3 = (float*)(ws + WS_SS3);
    float* biasw = (float*)(ws + WS_BIAS); float* misc = (float*)(ws + WS_MISC); unsigned* qctr = (unsigned*)(ws + WS_MISC + 64);
    LAS unsigned char* ldsl = (LAS unsigned char*)lds;
    if (tid == 0) { *(volatile LAS unsigned*)(ldsl + LDS_MISC + 16) = 0u; *(volatile LAS unsigned*)(ldsl + LDS_MISC + 20) = 0u; }
    __syncthreads();
    XcdBarrier xbar = xcd_barrier_post((unsigned*)(ws + WS_BAR), (volatile LAS unsigned*)(ldsl + LDS_MISC + 16));

#if PH_0
    {
        float* tile = (float*)lds;
        transpose_cvt(p.in[6], DM, INW, p.in[5], WIN, tile, bx, G);
        for (int row = bx * 8 + wid; row < T_ALL; row += G * 8) {
            const float* xr = (row < T_P) ? p.in[0] + (size_t)row * DM : p.in[1] + (size_t)(row - T_P) * DM;
            f32x4 xa[4], xb_[4]; float s = 0.f;
#pragma unroll
            for (int i = 0; i < 4; ++i) { const int c = (i * 64 + lane) * 8; xa[i] = *(const f32x4*)(xr + c); xb_[i] = *(const f32x4*)(xr + c + 4); }
#pragma unroll
            for (int i = 0; i < 4; ++i) { const f32x4 a = xa[i], b = xb_[i];
                s += (a[0] * a[0] + a[1] * a[1]) + (a[2] * a[2] + a[3] * a[3]) + (b[0] * b[0] + b[1] * b[1]) + (b[2] * b[2] + b[3] * b[3]); }
            s = wave_sum(s);
            const float rs = 1.0f / sqrtf(s * (1.0f / DM) + EPS);
#pragma unroll
            for (int i = 0; i < 4; ++i) { const int c = (i * 64 + lane) * 8; const f32x4 a = xa[i] * rs, b = xb_[i] * rs;
                u32x4 w; w.x = cvt_pk_bf16(a[0], a[1]); w.y = cvt_pk_bf16(a[2], a[3]); w.z = cvt_pk_bf16(b[0], b[1]); w.w = cvt_pk_bf16(b[2], b[3]);
                *(u32x4*)(XB + (size_t)row * DM + c) = w; }
        }
        for (int i = bx * 512 + tid; i < T_ALL; i += G * 512) { ss2[i] = 0.f; ss3[i] = 0.f; }
        if (bx == 0) {
            for (int i = tid; i < 4 * 384; i += 512) { const int h = i / 384, rel = (i % 384) - 192; biasw[i] = p.in[4][rel_bucket_dev(rel) * 4 + h] * LOG2E; }
            if (wid == 0) {
                float a = p.in[17][lane] * p.in[18][lane] + p.in[17][lane + 64] * p.in[18][lane + 64];
                float b = p.in[19][lane] * p.in[20][lane] + p.in[19][lane + 64] * p.in[20][lane + 64];
                a = wave_sum(a); b = wave_sum(b);
                if (lane == 0) { misc[0] = expf(a) - expf(b) + 0.2f; qctr[0] = 0u; qctr[1] = 0u; qctr[2] = 0u; }
            }
        }
    }
#endif
    grid.sync();
#if PH_1
    {
        pg8::Gemm g{XB, DM, WIN, T_ALL, INW, DM}; pg8::StaticOrder S; S.init(T_ALL, INW, G, bx);
        EpiG1 E{P, rstd1};
        pg8::gemm_phase<EpiG1>(ldsl, g, S, E);
    }
#endif
    xcd_barrier(xbar);
#if PH_2
    {
        for (;;) {
            __syncthreads();
            if (tid == 0) *(volatile int*)(lds + LDS_MISC) = (int)atomicAdd(qctr, 1u);
            __syncthreads();
            const int item = __builtin_amdgcn_readfirstlane(*(volatile int*)(lds + LDS_MISC));
            if (item >= 160) break;
            int seq, gq, tok0, L;
            if (item < 32) { seq = item >> 3; gq = item & 7; tok0 = seq * 4096; L = 4096; }
            else { const int it = item - 32; seq = it >> 3; gq = it & 7; tok0 = T_P + seq * 2048; L = 2048; }
            scan_wave(p, (char*)lds + wid * SC_WAVE_LDS, tok0, L, gq * 8 + wid, lane);
        }
        const float lam = __uint_as_float(__builtin_amdgcn_readfirstlane(__float_as_uint(misc[0])));
        for (;;) {
            __syncthreads();
            if (tid == 0) *(volatile int*)(lds + LDS_MISC) = (int)atomicAdd(qctr + 1, 1u);
            __syncthreads();
            const int item = __builtin_amdgcn_readfirstlane(*(volatile int*)(lds + LDS_MISC));
            if (item >= 768) break;
            int b, h, qb, tok0, L;
            if (item < 256) { b = item >> 6; h = (item >> 4) & 3; qb = item & 15; L = 4096; tok0 = b * 4096; }
            else { const int it = item - 256; b = it >> 5; h = (it >> 3) & 3; qb = it & 7; L = 2048; tok0 = T_P + b * 2048; }
            LAS float* tab = (LAS float*)(ldsl + att::OFF_TAB);
            if (tid < 384) tab[tid] = biasw[h * 384 + tid];
            const float cL = __uint_as_float(__builtin_amdgcn_readfirstlane(__float_as_uint(biasw[h * 384 + 0]))), cR = __uint_as_float(__builtin_amdgcn_readfirstlane(__float_as_uint(biasw[h * 384 + 383])));
            const int q0 = qb * 256;
            const bf16_t* Pq = P + (size_t)(tok0 + q0) * INW;
            const bf16_t* Ps = P + (size_t)tok0 * INW;
            float* Ob = OSC + (size_t)(tok0 + q0) * 1024 + h * 256;
#pragma unroll 1
            for (int pass = 0; pass < 2; ++pass) {
                __syncthreads();
                att::attn_pass(Pq + COL_Q + h * 256 + pass * 128, Ps + COL_K + h * 256 + pass * 128, Ps + COL_V + h * 256,
                               Ob, L, (char*)lds, pass, lam, tab, cL, cR, q0);
            }
            __builtin_amdgcn_fence(__ATOMIC_RELEASE, "agent");
            __syncthreads();
            __builtin_amdgcn_fence(__ATOMIC_ACQUIRE, "agent");
            int ln = lane; asm volatile("" : "+v"(ln));
            const f32x4 sg = *(const f32x4*)(p.in[21] + ln * 4);
            for (int rb = wid; rb < 256; rb += 128) {
                f32x4 vv[16]; u32x2 azz[16];
#pragma unroll
                for (int k = 0; k < 16; ++k) { const size_t tok = (size_t)(tok0 + q0 + rb + 8 * k);
                    vv[k] = *(const f32x4*)(OSC + tok * 1024 + h * 256 + ln * 4); azz[k] = *(const u32x2*)(P + tok * INW + COL_AZ + h * 256 + ln * 4); }
#pragma unroll
                for (int k = 0; k < 16; ++k) { const size_t tok = (size_t)(tok0 + q0 + rb + 8 * k); const f32x4 v = vv[k]; const u32x2 az = azz[k];
                    float s = (v[0] * v[0] + v[1] * v[1]) + (v[2] * v[2] + v[3] * v[3]); s = wave_sum(s);
                    const float rs = 0.8f / sqrtf(s * (1.0f / 256.0f) + EPS);
                    u32x2 w; w.x = cvt_pk_bf16(v[0] * rs * sg[0] * bf_lo(az.x), v[1] * rs * sg[1] * bf_hi(az.x));
                    w.y = cvt_pk_bf16(v[2] * rs * sg[2] * bf_lo(az.y), v[3] * rs * sg[3] * bf_hi(az.y));
                    *(u32x2*)(P + tok * INW + COL_Q + h * 256 + ln * 4) = w; }
            }
        }
            for (;;) {
            __syncthreads();
            if (tid == 0) *(volatile int*)(lds + LDS_MISC) = (int)atomicAdd(qctr + 2, 1u);
            __syncthreads();
            const int it = __builtin_amdgcn_readfirstlane(*(volatile int*)(lds + LDS_MISC));
            if (it >= 1632) break;
            float* tile = (float*)lds;
            if (it < 64) transpose_cvt(p.in[15], 1024, 1024, nullptr, WGLU, tile, it, 64);
            else if (it < 192) transpose_cvt(p.in[22], 1024, DM, nullptr, WBS, tile, it - 64, 128);
            else if (it < 320) transpose_cvt(p.in[23], 1024, DM, nullptr, WBA, tile, it - 192, 128);
            else if (it < 576) transpose_cvt(p.in[24], DM, DM, nullptr, WOUT, tile, it - 320, 256);
            else if (it < 832) transpose_cvt(p.in[26], DM, DM, p.in[25], WPG, tile, it - 576, 256);
            else if (it < 864) transpose_cvt(p.in[27], PLE, DM, nullptr, WPP, tile, it - 832, 32);
            else {
                const size_t base = (size_t)(it - 864) * 16384;
#pragma unroll
                for (int k = 0; k < 4; ++k) { const size_t e = base + ((size_t)k * 512 + tid) * 8; const float* src = (e < (size_t)T_P * PLE) ? p.in[2] + e : p.in[3] + (e - (size_t)T_P * PLE);
                    const f32x4 a = *(const f32x4*)src, b = *(const f32x4*)(src + 4);
                    u32x4 w; w.x = cvt_pk_bf16(a[0], a[1]); w.y = cvt_pk_bf16(a[2], a[3]); w.z = cvt_pk_bf16(b[0], b[1]); w.w = cvt_pk_bf16(b[2], b[3]);
                    *(u32x4*)(PB + e) = w; }
            }
        }
    }
#endif
    xcd_barrier(xbar);
#if PH_3
    {
        pg8::Gemm g{P + COL_SX, INW, WGLU, T_ALL, 1024, 1024}; pg8::StaticOrder S; S.init(T_ALL, 1024, G, bx);
        EpiD1 E{P, p.in[16], Y2};
        pg8::gemm_phase<EpiD1>(ldsl, g, S, E);
    }
    {
        pg8::Gemm g{PB, PLE, WPP, T_ALL, DM, PLE}; pg8::StaticOrder S; S.init(T_ALL, DM, G, bx);
        EpiGate<2> E{P};
        pg8::gemm_phase<EpiGate<2>>(ldsl, g, S, E);
    }
#endif
    xcd_barrier(xbar);
#if PH_4
    {
        pg8::Gemm g{Y2, 1024, WBS, T_ALL, DM, 1024}; pg8::StaticOrder S; S.init(T_ALL, DM, G, bx);
        EpiGate<0> E{P};
        pg8::gemm_phase<EpiGate<0>>(ldsl, g, S, E);
    }
    {
        pg8::Gemm g{P + COL_Q, INW, WBA, T_ALL, DM, 1024}; pg8::StaticOrder S; S.init(T_ALL, DM, G, bx);
        EpiGate<1> E{P};
        pg8::gemm_phase<EpiGate<1>>(ldsl, g, S, E);
    }
#endif
    xcd_barrier(xbar);
#if PH_5
    {
        pg8::Gemm g{P + COL_GS, INW, WOUT, T_ALL, DM, DM}; pg8::StaticOrder S; S.init(T_ALL, DM, G, bx);
        EpiD3 E{p.in[0], p.in[1], P, ss2};
        pg8::gemm_phase<EpiD3>(ldsl, g, S, E);
    }
#endif
    xcd_barrier(xbar);
#if PH_6
    {
        pg8::Gemm g{P + COL_HB, INW, WPG, T_ALL, DM, DM}; pg8::StaticOrder S; S.init(T_ALL, DM, G, bx);
        EpiD4 E{P, ss2, ss3};
        pg8::gemm_phase<EpiD4>(ldsl, g, S, E);
    }
#endif
    xcd_barrier(xbar);
    for (int row = (bx * 8 + wid) * 2; row < T_ALL; row += G * 16) {
        u32x4 hw[2][4]; float ssv[2];
#pragma unroll
        for (int rr = 0; rr < 2; ++rr) { ssv[rr] = ss3[row + rr]; const bf16_t* hrow = P + (size_t)(row + rr) * INW + COL_H2;
#pragma unroll
            for (int i = 0; i < 4; ++i) hw[rr][i] = *(const u32x4*)(hrow + (i * 64 + lane) * 8); }
#pragma unroll
        for (int rr = 0; rr < 2; ++rr) { const float rs = 1.0f / sqrtf(ssv[rr] * (1.0f / DM) + EPS); float* o = p.out + (size_t)(row + rr) * DM;
#pragma unroll
            for (int i = 0; i < 4; ++i) { const int c = (i * 64 + lane) * 8; const u32x4 h = hw[rr][i];
                const f32x4 g0 = *(const f32x4*)(p.in[28] + c), g1 = *(const f32x4*)(p.in[28] + c + 4);
                *(f32x4*)(o + c) = (f32x4){bf_lo(h.x), bf_hi(h.x), bf_lo(h.y), bf_hi(h.y)} * rs * g0;
                *(f32x4*)(o + c + 4) = (f32x4){bf_lo(h.z), bf_hi(h.z), bf_lo(h.w), bf_hi(h.w)} * rs * g1; } }
    }
}

extern "C" void kernel_launch(void* const* d_in, const int* in_sizes, int n_in, void* d_out, int out_size, void* d_ws, size_t ws_size, hipStream_t stream) {
    static int grid_blocks = 0;
    if (grid_blocks == 0) {
        if (n_in != 29 || ws_size < WS_END || out_size != T_ALL * DM) { fprintf(stderr, "kernel_launch: unexpected shapes n_in %d ws %zu out %d\n", n_in, ws_size, out_size); grid_blocks = -1; return; }
        int dev = 0, cus = 0, per_cu = 0;
        hipGetDevice(&dev); hipDeviceGetAttribute(&cus, hipDeviceAttributeMultiprocessorCount, dev);
        if (hipFuncSetAttribute((const void*)hybrid_fwd, hipFuncAttributeMaxDynamicSharedMemorySize, LDS_BYTES) != hipSuccess) { fprintf(stderr, "kernel_launch: hipFuncSetAttribute failed\n"); grid_blocks = -1; return; }
        if (hipOccupancyMaxActiveBlocksPerMultiprocessor(&per_cu, (const void*)hybrid_fwd, 512, LDS_BYTES) != hipSuccess || per_cu < 1) { fprintf(stderr, "kernel_launch: occupancy query says %d\n", per_cu); per_cu = 1; }
        (void)hipGetLastError();
        grid_blocks = cus;
    }
    if (grid_blocks < 0) return;
    if (hipMemsetAsync((char*)d_ws + WS_BAR, 0, 16384, stream) != hipSuccess) { fprintf(stderr, "kernel_launch: memset failed\n"); return; }
    Params p{};
    for (int i = 0; i < 29; ++i) p.in[i] = (const float*)d_in[i];
    p.out = (float*)d_out; p.ws = (unsigned char*)d_ws;
    void* args[] = {&p};
    hipError_t e = hipLaunchCooperativeKernel((const void*)hybrid_fwd, dim3(grid_blocks), dim3(512), args, LDS_BYTES, stream);
    if (e != hipSuccess) fprintf(stderr, "cooperative launch failed: %s (grid %d)\n", hipGetErrorString(e), grid_blocks);
}
```

```cpp
#include <hip/hip_runtime.h>
#include <hip/hip_cooperative_groups.h>
#include <cstdio>
#include <cstdint>
namespace cg = cooperative_groups;

#define LAS __attribute__((address_space(3)))
typedef unsigned short bf16_t;
typedef short bf16x8 __attribute__((ext_vector_type(8)));
typedef short s16x4 __attribute__((ext_vector_type(4)));
typedef float f32x2 __attribute__((ext_vector_type(2)));
typedef float f32x4 __attribute__((ext_vector_type(4)));
typedef float f32x16 __attribute__((ext_vector_type(16)));
typedef unsigned u32x2 __attribute__((ext_vector_type(2)));
typedef unsigned u32x4 __attribute__((ext_vector_type(4)));

constexpr int T_P = 16384, T_ALL = 49152, DM = 2048, INW = 10240, PLE = 256;
constexpr int COL_SX = 0, COL_SZ = 1024, COL_Q = 2048, COL_K = 3072, COL_V = 4096, COL_AZ = 5120, COL_GS = 6144, COL_GA = 8192;
constexpr int COL_HB = 2048, COL_PP = 4096, COL_H2 = 0;
constexpr float EPS = 1e-6f;
constexpr float LOG2E = 1.4426950408889634f;
constexpr size_t MiB = 1048576;
constexpr size_t WS_P = 0;
constexpr size_t WS_WGLU = 960 * MiB;
constexpr size_t WS_WBS = WS_WGLU + 2 * MiB;
constexpr size_t WS_WBA = WS_WBS + 4 * MiB;
constexpr size_t WS_WOUT = WS_WBA + 4 * MiB;
constexpr size_t WS_WPG = WS_WOUT + 8 * MiB;
constexpr size_t WS_WPP = WS_WPG + 8 * MiB;
constexpr size_t WS_PB = WS_WPP + 1 * MiB;
constexpr size_t WS_RSTD1 = WS_PB + 24 * MiB;
constexpr size_t WS_SS2 = WS_RSTD1 + 256 * 1024;
constexpr size_t WS_SS3 = WS_SS2 + 256 * 1024;
constexpr size_t WS_BIAS = WS_SS3 + 256 * 1024;
constexpr size_t WS_MISC = WS_BIAS + 8192;
constexpr size_t WS_BAR = WS_MISC + 4096;
constexpr size_t WS_END = WS_BAR + 16384;
constexpr size_t DO_XB = 0;
constexpr size_t DO_WIN = 192 * MiB;
constexpr size_t DO_YF = 0;
constexpr size_t DO_OSC = 192 * MiB;
constexpr size_t DO_Y2 = 0;

struct Params { const float* in[29]; float* out; unsigned char* ws; };

__device__ __forceinline__ unsigned cvt_pk_bf16(float lo, float hi) { unsigned r; asm volatile("v_cvt_pk_bf16_f32 %0, %1, %2" : "=v"(r) : "v"(lo), "v"(hi)); return r; }
__device__ __forceinline__ float bf_lo(unsigned w) { return __uint_as_float(w << 16); }
__device__ __forceinline__ float bf_hi(unsigned w) { return __uint_as_float(w & 0xffff0000u); }
__device__ __forceinline__ float sigmoidf_(float x) { return __builtin_amdgcn_rcpf(1.0f + __builtin_amdgcn_exp2f(-x * LOG2E)); }
__device__ __forceinline__ float siluf_(float x) { return x * sigmoidf_(x); }
__device__ __forceinline__ float gelu_tanh(float x) { const float z = 0.7978845608028654f * (x + 0.044715f * x * x * x); return x * sigmoidf_(2.0f * z); }
__device__ __forceinline__ float wave_sum(float v) {
#pragma unroll
    for (int o = 32; o > 0; o >>= 1) v += __shfl_xor(v, o);
    return v;
}

namespace pg8 {
constexpr int BM = 256, BK = 64, HALF = 128, HTB = HALF * BK * 2, STAGE_BYTES = 8 * HTB, NXCD = 8, WGM = 8;
__host__ __device__ __forceinline__ int lds_byte(int r, int c) { const int st = (r >> 4) * 2 + (c >> 5), rr = r & 15, cc = c & 31, ob = rr * 64 + cc * 2; return st * 1024 + (ob ^ (((ob >> 9) & 1) << 5)); }
__host__ __device__ __forceinline__ void stage_rc(int b, int& R, int& C) { const int st = b / 1024, sb = b % 1024, swz = sb ^ (((sb >> 9) & 1) << 5); R = (st >> 1) * 16 + swz / 64; C = (st & 1) * 32 + (swz % 64) / 2; }
__host__ __device__ __forceinline__ int perm32(int rho) { const int n = rho >> 4, i = rho & 15; return 8 * (i >> 2) + 4 * n + (i & 3); }
struct Unit { int pm, pn; };
struct Gemm { const bf16_t* A; int lda; const bf16_t* Bt; int M, N, K; };
struct StaticOrder {
    int nM, nN, nwg, G, c;
    __device__ void init(int M, int N, int G_, int c_) { nM = M / BM; nN = N / BM; nwg = nM * nN; G = G_; c = c_; }
    __device__ bool next(int i, Unit& u) const {
        const long L = (long)i * G + c; if (L >= nwg) return false;
        int wgid = (int)L; { const int q = nwg / NXCD, r = nwg % NXCD, xcd = wgid % NXCD, off = wgid / NXCD; wgid = (xcd < r ? xcd * (q + 1) : r * (q + 1) + (xcd - r) * q) + off; }
        const int nig = WGM * nN, gid = wgid / nig, fm = gid * WGM, gsz = (nM - fm) < WGM ? (nM - fm) : WGM;
        u.pm = fm + ((wgid % nig) % gsz); u.pn = (wgid % nig) / gsz; return true;
    }
};

template <class Epi>
__device__ __forceinline__ void gemm_phase(LAS unsigned char* lds, const Gemm g, const StaticOrder& S, const Epi& E) {
    int tid = threadIdx.x; asm volatile("" : "+v"(tid));
    const int wid = __builtin_amdgcn_readfirstlane(tid >> 6), lane = tid & 63, wr = wid >> 2, wc = wid & 3, fr = lane & 15, fq = lane >> 4;
    const int K = g.K, nt = K / BK, lda = g.lda;
    unsigned voffA[2], voffB[2];
#pragma unroll
    for (int i = 0; i < 2; ++i) { int R, C; stage_rc(tid * 16 + i * 8192, R, C); const int Rb = Epi::PERM ? ((R & ~31) + perm32(R & 31)) : R;
        voffA[i] = (unsigned)(R * lda + C) * 2u; voffB[i] = (unsigned)(Rb * K + C) * 2u; }
    const size_t kstep = (size_t)(BK * 2);
    const size_t hstepA = (size_t)HALF * lda * 2, hstepB = (size_t)HALF * K * 2;
    const size_t tstepA = 2 * hstepA, tstepB = 2 * hstepB;
    const unsigned ldsw = (unsigned)wid * 1024u;
    const int aoff = lds_byte(wr * 64 + fr, fq * 8), boff = lds_byte(wc * 32 + fr, fq * 8);
#define PG8_SA(b, h) (((b) * 2 + (h)) * HTB)
#define PG8_SB(b, h) ((4 + (b) * 2 + (h)) * HTB)
#define PG8_STAGE(bufoff, gbase, voff) do { _Pragma("unroll") for (int _i = 0; _i < 2; ++_i) \
        __builtin_amdgcn_global_load_lds((const unsigned*)((const char*)(gbase) + (voff)[_i]), (LAS unsigned*)(lds + (bufoff) + ldsw + _i * 8192), 16, 0, 0); } while (0)
#define PG8_LDA(dst, b, h) do { _Pragma("unroll") for (int m = 0; m < 4; ++m) _Pragma("unroll") for (int k = 0; k < 2; ++k) dst[m][k] = *(const LAS bf16x8*)(lds + PG8_SA(b, h) + aoff + m * 2048 + k * 1024); } while (0)
#define PG8_LDB(dst, b, h) do { _Pragma("unroll") for (int n = 0; n < 2; ++n) _Pragma("unroll") for (int k = 0; k < 2; ++k) dst[n][k] = *(const LAS bf16x8*)(lds + PG8_SB(b, h) + boff + n * 2048 + k * 1024); } while (0)
#define PG8_MMA(ai, bj, At, Bt) do { __builtin_amdgcn_s_setprio(1); _Pragma("unroll") for (int m = 0; m < 4; ++m) _Pragma("unroll") for (int n = 0; n < 2; ++n) _Pragma("unroll") for (int k = 0; k < 2; ++k) \
        acc[ai][bj][m][n] = __builtin_amdgcn_mfma_f32_16x16x32_bf16(Bt[n][k], At[m][k], acc[ai][bj][m][n], 0, 0, 0); __builtin_amdgcn_s_setprio(0); } while (0)
#define PG8_WAIT_V(n) asm volatile("s_waitcnt vmcnt(" #n ")" ::: "memory")
#define PG8_WAIT_L(n) asm volatile("s_waitcnt lgkmcnt(" #n ")" ::: "memory")
#define PG8_BAR __builtin_amdgcn_s_barrier()
#define PG8_SCHED __builtin_amdgcn_sched_barrier(0)
    Unit cur, nxt; int ui = 0;
    if (!S.next(0, cur)) return;
    f32x4 acc[2][2][4][2];
#pragma unroll
    for (int a = 0; a < 2; ++a)
#pragma unroll
        for (int b = 0; b < 2; ++b)
#pragma unroll
            for (int m = 0; m < 4; ++m)
#pragma unroll
                for (int n = 0; n < 2; ++n) acc[a][b][m][n] = (f32x4){0.f, 0.f, 0.f, 0.f};
    bf16x8 At[4][2], B0[2][2], B1[2][2];
    const char* cA = (const char*)g.A + (size_t)cur.pm * tstepA; const char* cB = (const char*)g.Bt + (size_t)cur.pn * tstepB;
    PG8_STAGE(PG8_SB(0, 0), cB, voffB); PG8_STAGE(PG8_SA(0, 0), cA, voffA); PG8_STAGE(PG8_SB(0, 1), cB + hstepB, voffB); PG8_STAGE(PG8_SA(0, 1), cA + hstepA, voffA);
    if (wr == 1) PG8_BAR;
    PG8_WAIT_V(4); PG8_BAR;
    PG8_STAGE(PG8_SB(1, 0), cB + kstep, voffB); PG8_STAGE(PG8_SA(1, 0), cA + kstep, voffA); PG8_STAGE(PG8_SB(1, 1), cB + hstepB + kstep, voffB);
    PG8_WAIT_V(6); PG8_BAR;
    for (;;) {
        const bool has_next = S.next(ui + 1, nxt);
        const char* nA = has_next ? (const char*)g.A + (size_t)nxt.pm * tstepA : cA; const char* nB = has_next ? (const char*)g.Bt + (size_t)nxt.pn * tstepB : cB;
        for (int t = 0; t < nt; t += 2) {
            const bool last = (t == nt - 2);
            const char* a1 = cA + (size_t)(t + 1) * kstep;
            const char* a2 = last ? nA : cA + (size_t)(t + 2) * kstep; const char* b2 = last ? nB : cB + (size_t)(t + 2) * kstep;
            const char* a3 = a2 + kstep; const char* b3 = b2 + kstep;
            PG8_LDB(B0, 0, 0); PG8_SCHED; PG8_LDA(At, 0, 0); PG8_STAGE(PG8_SA(1, 1), a1 + hstepA, voffA);
            PG8_WAIT_L(8); PG8_BAR; PG8_WAIT_L(0); PG8_MMA(0, 0, At, B0); PG8_BAR; PG8_SCHED;
            PG8_LDB(B1, 0, 1); PG8_STAGE(PG8_SB(0, 0), b2, voffB);
            PG8_BAR; PG8_WAIT_L(0); PG8_MMA(0, 1, At, B1); PG8_BAR;
            PG8_LDA(At, 0, 1); PG8_STAGE(PG8_SA(0, 0), a2, voffA);
            PG8_BAR; PG8_WAIT_L(0); PG8_MMA(1, 0, At, B0); PG8_BAR; PG8_SCHED;
            PG8_STAGE(PG8_SB(0, 1), b2 + hstepB, voffB);
            PG8_WAIT_V(6); PG8_BAR; PG8_MMA(1, 1, At, B1); PG8_BAR;
            PG8_LDB(B0, 1, 0); PG8_SCHED; PG8_LDA(At, 1, 0); PG8_STAGE(PG8_SA(0, 1), a2 + hstepA, voffA);
            PG8_WAIT_L(8); PG8_BAR; PG8_WAIT_L(0); PG8_MMA(0, 0, At, B0); PG8_BAR; PG8_SCHED;
            PG8_LDB(B1, 1, 1); PG8_STAGE(PG8_SB(1, 0), b3, voffB);
            PG8_BAR; PG8_WAIT_L(0); PG8_MMA(0, 1, At, B1); PG8_BAR;
            PG8_LDA(At, 1, 1); PG8_STAGE(PG8_SA(1, 0), a3, voffA);
            PG8_BAR; PG8_WAIT_L(0); PG8_MMA(1, 0, At, B0); PG8_BAR; PG8_SCHED;
            PG8_STAGE(PG8_SB(1, 1), b3 + hstepB, voffB);
            PG8_WAIT_V(6); PG8_BAR; PG8_MMA(1, 1, At, B1); PG8_BAR;
        }
        E(acc, cur, wr, wc, fr, fq);
        if (!has_next) break;
#pragma unroll
        for (int a = 0; a < 2; ++a)
#pragma unroll
            for (int b = 0; b < 2; ++b)
#pragma unroll
                for (int m = 0; m < 4; ++m)
#pragma unroll
                    for (int n = 0; n < 2; ++n) acc[a][b][m][n] = (f32x4){0.f, 0.f, 0.f, 0.f};
        cur = nxt; cA = nA; cB = nB; ++ui;
    }
    PG8_WAIT_V(0);
    if (wr == 0) PG8_BAR;
    PG8_BAR;
#undef PG8_SA
#undef PG8_SB
#undef PG8_STAGE
#undef PG8_LDA
#undef PG8_LDB
#undef PG8_MMA
#undef PG8_WAIT_V
#undef PG8_WAIT_L
#undef PG8_BAR
#undef PG8_SCHED
}
}

typedef f32x4 AccT[2][2][4][2];

struct EpiG1 {
    static constexpr bool PERM = true;
    bf16_t* P; const float* rstd1;
    __device__ __forceinline__ void operator()(const AccT& acc, const pg8::Unit& u, int wr, int wc, int fr, int fq) const {
        const int row0 = u.pm * 256 + wr * 64 + fr, col0 = u.pn * 256 + wc * 32 + 8 * fq;
        const int pn = u.pn; const int mode = (pn >= 24) ? 2 : ((pn >= 4 && pn < 8) || (pn >= 20)) ? 1 : 0;
#pragma unroll
        for (int ai = 0; ai < 2; ++ai)
#pragma unroll
            for (int m = 0; m < 4; ++m) { const int row = row0 + ai * 128 + m * 16; bf16_t* rowp = P + (size_t)row * INW + col0;
#pragma unroll
                for (int bj = 0; bj < 2; ++bj) { float v[8];
#pragma unroll
                    for (int j = 0; j < 4; ++j) { v[j] = acc[ai][bj][m][0][j]; v[4 + j] = acc[ai][bj][m][1][j]; }
                    if (mode == 1) {
#pragma unroll
                        for (int j = 0; j < 8; ++j) v[j] = siluf_(v[j]); }
                    else if (mode == 2) {
#pragma unroll
                        for (int j = 0; j < 8; ++j) v[j] = sigmoidf_(v[j]); }
                    u32x4 w; w.x = cvt_pk_bf16(v[0], v[1]); w.y = cvt_pk_bf16(v[2], v[3]); w.z = cvt_pk_bf16(v[4], v[5]); w.w = cvt_pk_bf16(v[6], v[7]);
                    *(u32x4*)(rowp + bj * 128) = w; } }
    }
};
struct EpiD1 {
    static constexpr bool PERM = true;
    const bf16_t* P; const float* glu_b; bf16_t* Y2;
    __device__ __forceinline__ void operator()(const AccT& acc, const pg8::Unit& u, int wr, int wc, int fr, int fq) const {
        const int row0 = u.pm * 256 + wr * 64 + fr, col0 = u.pn * 256 + wc * 32 + 8 * fq;
        f32x4 b0[2], b1[2];
#pragma unroll
        for (int bj = 0; bj < 2; ++bj) { b0[bj] = *(const f32x4*)(glu_b + col0 + bj * 128); b1[bj] = *(const f32x4*)(glu_b + col0 + bj * 128 + 4); }
#pragma unroll
        for (int ai = 0; ai < 2; ++ai) {
            u32x4 yg[4][2], sz[4][2];
#pragma unroll
            for (int m = 0; m < 4; ++m)
#pragma unroll
                for (int bj = 0; bj < 2; ++bj) { const bf16_t* pr = P + (size_t)(row0 + ai * 128 + m * 16) * INW + col0 + bj * 128;
                    yg[m][bj] = *(const u32x4*)(pr + COL_SX); sz[m][bj] = *(const u32x4*)(pr + COL_SZ); }
#pragma unroll
            for (int m = 0; m < 4; ++m)
#pragma unroll
                for (int bj = 0; bj < 2; ++bj) { const int row = row0 + ai * 128 + m * 16, col = col0 + bj * 128;
                    const f32x4 t0 = acc[ai][bj][m][0] + b0[bj], t1 = acc[ai][bj][m][1] + b1[bj]; const u32x4 g = yg[m][bj], z = sz[m][bj]; float v[8];
                    v[0] = bf_lo(g.x) * sigmoidf_(t0[0]) * bf_lo(z.x); v[1] = bf_hi(g.x) * sigmoidf_(t0[1]) * bf_hi(z.x);
                    v[2] = bf_lo(g.y) * sigmoidf_(t0[2]) * bf_lo(z.y); v[3] = bf_hi(g.y) * sigmoidf_(t0[3]) * bf_hi(z.y);
                    v[4] = bf_lo(g.z) * sigmoidf_(t1[0]) * bf_lo(z.z); v[5] = bf_hi(g.z) * sigmoidf_(t1[1]) * bf_hi(z.z);
                    v[6] = bf_lo(g.w) * sigmoidf_(t1[2]) * bf_lo(z.w); v[7] = bf_hi(g.w) * sigmoidf_(t1[3]) * bf_hi(z.w);
                    u32x4 w; w.x = cvt_pk_bf16(v[0], v[1]); w.y = cvt_pk_bf16(v[2], v[3]); w.z = cvt_pk_bf16(v[4], v[5]); w.w = cvt_pk_bf16(v[6], v[7]);
                    *(u32x4*)(Y2 + (size_t)row * 1024 + col) = w; }
        }
    }
};
template <int MODE> struct EpiGate {
    static constexpr bool PERM = true;
    bf16_t* P;
    __device__ __forceinline__ void operator()(const AccT& acc, const pg8::Unit& u, int wr, int wc, int fr, int fq) const {
        const int row0 = u.pm * 256 + wr * 64 + fr, col0 = u.pn * 256 + wc * 32 + 8 * fq;
        u32x4 gs[2][4][2];
        if (MODE == 0) {
#pragma unroll
            for (int ai = 0; ai < 2; ++ai)
#pragma unroll
                for (int m = 0; m < 4; ++m)
#pragma unroll
                    for (int bj = 0; bj < 2; ++bj) gs[ai][m][bj] = *(const u32x4*)(P + (size_t)(row0 + ai * 128 + m * 16) * INW + col0 + bj * 128 + COL_GS);
        }
#pragma unroll
        for (int ai = 0; ai < 2; ++ai) {
            u32x4 ga[4][2];
            if (MODE == 1) {
#pragma unroll
                for (int m = 0; m < 4; ++m)
#pragma unroll
                    for (int bj = 0; bj < 2; ++bj) { const bf16_t* pr = P + (size_t)(row0 + ai * 128 + m * 16) * INW + col0 + bj * 128;
                        gs[ai][m][bj] = *(const u32x4*)(pr + COL_GS); ga[m][bj] = *(const u32x4*)(pr + COL_GA); }
            }
#pragma unroll
            for (int m = 0; m < 4; ++m)
#pragma unroll
                for (int bj = 0; bj < 2; ++bj) { bf16_t* pr = P + (size_t)(row0 + ai * 128 + m * 16) * INW + col0 + bj * 128; const f32x4 a0 = acc[ai][bj][m][0], a1 = acc[ai][bj][m][1]; float v[8];
                    if (MODE == 2) { v[0] = a0[0]; v[1] = a0[1]; v[2] = a0[2]; v[3] = a0[3]; v[4] = a1[0]; v[5] = a1[1]; v[6] = a1[2]; v[7] = a1[3]; }
                    else if (MODE == 0) { const u32x4 g = gs[ai][m][bj]; v[0] = bf_lo(g.x) * a0[0]; v[1] = bf_hi(g.x) * a0[1]; v[2] = bf_lo(g.y) * a0[2]; v[3] = bf_hi(g.y) * a0[3];
                        v[4] = bf_lo(g.z) * a1[0]; v[5] = bf_hi(g.z) * a1[1]; v[6] = bf_lo(g.w) * a1[2]; v[7] = bf_hi(g.w) * a1[3]; }
                    else { const u32x4 g = gs[ai][m][bj], h = ga[m][bj];
                        v[0] = bf_lo(g.x) + bf_lo(h.x) * a0[0]; v[1] = bf_hi(g.x) + bf_hi(h.x) * a0[1]; v[2] = bf_lo(g.y) + bf_lo(h.y) * a0[2]; v[3] = bf_hi(g.y) + bf_hi(h.y) * a0[3];
                        v[4] = bf_lo(g.z) + bf_lo(h.z) * a1[0]; v[5] = bf_hi(g.z) + bf_hi(h.z) * a1[1]; v[6] = bf_lo(g.w) + bf_lo(h.w) * a1[2]; v[7] = bf_hi(g.w) + bf_hi(h.w) * a1[3]; }
                    u32x4 w; w.x = cvt_pk_bf16(v[0], v[1]); w.y = cvt_pk_bf16(v[2], v[3]); w.z = cvt_pk_bf16(v[4], v[5]); w.w = cvt_pk_bf16(v[6], v[7]);
                    *(u32x4*)(pr + (MODE == 2 ? COL_PP : COL_GS)) = w; }
        }
    }
};
struct EpiD3 {
    static constexpr bool PERM = false;
    const float* xp; const float* xs; bf16_t* P; float* ss2;
    __device__ __forceinline__ void operator()(const AccT& acc, const pg8::Unit& u, int wr, int wc, int fr, int fq) const {
        const int row0 = u.pm * 256 + wr * 64 + fr, col0 = u.pn * 256 + wc * 32 + 4 * fq;
        const float* xbase = (u.pm * 256 < T_P) ? xp : xs - (size_t)T_P * DM;
        u32x2 pk[2][4][2][2];
#pragma unroll
        for (int ai = 0; ai < 2; ++ai)
#pragma unroll
            for (int m = 0; m < 4; ++m)
#pragma unroll
                for (int bj = 0; bj < 2; ++bj)
#pragma unroll
                    for (int n = 0; n < 2; ++n) { const f32x4 a = acc[ai][bj][m][n]; pk[ai][m][bj][n].x = cvt_pk_bf16(a[0], a[1]); pk[ai][m][bj][n].y = cvt_pk_bf16(a[2], a[3]); }
        f32x4 xv[2][4][2][2];
#pragma unroll
        for (int ai = 0; ai < 2; ++ai)
#pragma unroll
            for (int m = 0; m < 4; ++m)
#pragma unroll
                for (int bj = 0; bj < 2; ++bj)
#pragma unroll
                    for (int n = 0; n < 2; ++n) xv[ai][m][bj][n] = *(const f32x4*)(xbase + (size_t)(row0 + ai * 128 + m * 16) * DM + col0 + bj * 128 + n * 16);
#pragma unroll
        for (int ai = 0; ai < 2; ++ai)
#pragma unroll
            for (int m = 0; m < 4; ++m) { const int row = row0 + ai * 128 + m * 16; float s = 0.f;
#pragma unroll
                for (int bj = 0; bj < 2; ++bj)
#pragma unroll
                    for (int n = 0; n < 2; ++n) { const int col = col0 + bj * 128 + n * 16; const u32x2 q = pk[ai][m][bj][n];
                        const f32x4 h = xv[ai][m][bj][n] + (f32x4){bf_lo(q.x), bf_hi(q.x), bf_lo(q.y), bf_hi(q.y)};
                        u32x2 w; w.x = cvt_pk_bf16(h[0], h[1]); w.y = cvt_pk_bf16(h[2], h[3]); *(u32x2*)(P + (size_t)row * INW + COL_HB + col) = w;
                        s += (h[0] * h[0] + h[1] * h[1]) + (h[2] * h[2] + h[3] * h[3]); }
                s += __shfl_xor(s, 16); s += __shfl_xor(s, 32);
                if (fq == 0) atomicAdd(ss2 + row, s); }
    }
};
struct EpiD4 {
    static constexpr bool PERM = false;
    bf16_t* P; const float* ss2; float* ss3;
    __device__ __forceinline__ void operator()(const AccT& acc, const pg8::Unit& u, int wr, int wc, int fr, int fq) const {
        const int row0 = u.pm * 256 + wr * 64 + fr, col0 = u.pn * 256 + wc * 32 + 4 * fq;
        u32x2 pk[2][4][2][2];
#pragma unroll
        for (int ai = 0; ai < 2; ++ai)
#pragma unroll
            for (int m = 0; m < 4; ++m)
#pragma unroll
                for (int bj = 0; bj < 2; ++bj)
#pragma unroll
                    for (int n = 0; n < 2; ++n) { const f32x4 a = acc[ai][bj][m][n]; pk[ai][m][bj][n].x = cvt_pk_bf16(a[0], a[1]); pk[ai][m][bj][n].y = cvt_pk_bf16(a[2], a[3]); }
        u32x2 hw[2][4][2][2], pw[2][4][2][2]; float rsv[2][4];
#pragma unroll
        for (int ai = 0; ai < 2; ++ai)
#pragma unroll
            for (int m = 0; m < 4; ++m) { rsv[ai][m] = ss2[row0 + ai * 128 + m * 16];
#pragma unroll
                for (int bj = 0; bj < 2; ++bj)
#pragma unroll
                    for (int n = 0; n < 2; ++n) { const bf16_t* pr = P + (size_t)(row0 + ai * 128 + m * 16) * INW + col0 + bj * 128 + n * 16;
                        hw[ai][m][bj][n] = *(const u32x2*)(pr + COL_HB); pw[ai][m][bj][n] = *(const u32x2*)(pr + COL_PP); } }
#pragma unroll
        for (int ai = 0; ai < 2; ++ai)
#pragma unroll
            for (int m = 0; m < 4; ++m) { const int row = row0 + ai * 128 + m * 16; float s = 0.f; const float r = __builtin_amdgcn_rsqf(rsv[ai][m] * (1.0f / DM) + EPS);
#pragma unroll
                for (int bj = 0; bj < 2; ++bj)
#pragma unroll
                    for (int n = 0; n < 2; ++n) { const int col = col0 + bj * 128 + n * 16; bf16_t* pr = P + (size_t)row * INW + col;
                        const u32x2 hq = hw[ai][m][bj][n], pq = pw[ai][m][bj][n], q = pk[ai][m][bj][n]; f32x4 h;
                        h[0] = bf_lo(hq.x) + sigmoidf_(bf_lo(q.x) * r) * bf_lo(pq.x); h[1] = bf_hi(hq.x) + sigmoidf_(bf_hi(q.x) * r) * bf_hi(pq.x);
                        h[2] = bf_lo(hq.y) + sigmoidf_(bf_lo(q.y) * r) * bf_lo(pq.y); h[3] = bf_hi(hq.y) + sigmoidf_(bf_hi(q.y) * r) * bf_hi(pq.y);
                        u32x2 w; w.x = cvt_pk_bf16(h[0], h[1]); w.y = cvt_pk_bf16(h[2], h[3]); *(u32x2*)(pr + COL_H2) = w;
                        s += (h[0] * h[0] + h[1] * h[1]) + (h[2] * h[2] + h[3] * h[3]); }
                s += __shfl_xor(s, 16); s += __shfl_xor(s, 32);
                if (fq == 0) atomicAdd(ss3 + row, s); }
    }
};

namespace att {
constexpr int D = 128, DV = 256, NW = 8, QBLK = 32, KVBLK = 32;
constexpr float SCALE = 0.088388347648318440f;
constexpr float THR2 = 8.f * LOG2E;
constexpr int LDQ = INW, LDK = INW, LDO = 1024;
constexpr int SHM_V = KVBLK * DV * 2, SHM_K = KVBLK * D * 2;
constexpr int OFF_V = 0, OFF_K = 2 * SHM_V, OFF_Q = OFF_K + 2 * SHM_K, OFF_W = OFF_Q + NW * QBLK * D * 2, OFF_TAB = OFF_W + NW * 64 * 4, SHM_ATTN = OFF_TAB + 384 * 4;
static_assert(SHM_ATTN <= 131072, "attention LDS");
#define KSWZ(row, colB) ((row) * 256 + ((colB) ^ (((row) & 7) << 4)))
#define SBAR() __builtin_amdgcn_sched_barrier(0)
__device__ __forceinline__ int crow(int r, int hi) { return (r & 3) + 8 * (r >> 2) + 4 * hi; }

struct BiasCtx { const LAS float* tab; float cL, cR; int qlo, qrow, hi; };
__device__ __forceinline__ void add_bias(f32x16& p0, int k0, const BiasCtx& B) {
    constexpr float C = SCALE * LOG2E;
    if (k0 + 31 - B.qlo <= -91) {
#pragma unroll
        for (int r = 0; r < 16; ++r) p0[r] = fmaf(p0[r], C, B.cL);
    } else if (k0 - (B.qlo + 31) >= 91) {
#pragma unroll
        for (int r = 0; r < 16; ++r) p0[r] = fmaf(p0[r], C, B.cR);
    } else {
        const LAS float* tb = B.tab + (k0 - B.qrow + 192 + 4 * B.hi);
#pragma unroll
        for (int r = 0; r < 16; ++r) p0[r] = fmaf(p0[r], C, tb[(r & 3) + 8 * (r >> 2)]);
    }
}
__device__ __forceinline__ void softmax_tile(f32x16& p0, float& m_reg, float& l_reg, float& alpha, int k0, const BiasCtx& B, bf16x8& pa0, bf16x8& pa1) {
    constexpr float C = SCALE * LOG2E;
    const bool farL = (k0 + 31 - B.qlo <= -91), farR = (k0 - (B.qlo + 31) >= 91);
    float mn;
    if (farL || farR) {
        const float cb = farL ? B.cL : B.cR;
        float pmax = p0[0];
#pragma unroll
        for (int r = 1; r < 16; ++r) pmax = fmaxf(pmax, p0[r]);
        { auto rr = __builtin_amdgcn_permlane32_swap(__float_as_uint(pmax), __float_as_uint(pmax), false, false);
          pmax = fmaxf(__uint_as_float(rr[0]), __uint_as_float(rr[1])); }
        pmax = fmaf(pmax, C, cb);
        if (__builtin_expect(__all(pmax - m_reg <= THR2), 1)) { mn = m_reg; alpha = 1.f; }
        else { mn = fmaxf(m_reg, pmax); alpha = __builtin_amdgcn_exp2f(m_reg - mn); m_reg = mn; }
        const float off = cb - mn;
#pragma unroll
        for (int r = 0; r < 16; ++r) p0[r] = __builtin_amdgcn_exp2f(fmaf(p0[r], C, off));
    } else {
        add_bias(p0, k0, B);
        float pmax = p0[0];
#pragma unroll
        for (int r = 1; r < 16; ++r) pmax = fmaxf(pmax, p0[r]);
        { auto rr = __builtin_amdgcn_permlane32_swap(__float_as_uint(pmax), __float_as_uint(pmax), false, false);
          pmax = fmaxf(__uint_as_float(rr[0]), __uint_as_float(rr[1])); }
        if (__builtin_expect(__all(pmax - m_reg <= THR2), 1)) { mn = m_reg; alpha = 1.f; }
        else { mn = fmaxf(m_reg, pmax); alpha = __builtin_amdgcn_exp2f(m_reg - mn); m_reg = mn; }
#pragma unroll
        for (int r = 0; r < 16; ++r) p0[r] = __builtin_amdgcn_exp2f(p0[r] - mn);
    }
    float ps = 0;
#pragma unroll
    for (int r = 0; r < 16; ++r) ps += p0[r];
    { auto rr = __builtin_amdgcn_permlane32_swap(__float_as_uint(ps), __float_as_uint(ps), false, false);
      ps = __uint_as_float(rr[0]) + __uint_as_float(rr[1]); }
    l_reg = l_reg * alpha + ps;
#define PK4(P, BASE, OUT) do { unsigned a0 = cvt_pk_bf16(P[BASE + 0], P[BASE + 1]), a1 = cvt_pk_bf16(P[BASE + 2], P[BASE + 3]);   \
    unsigned b0 = cvt_pk_bf16(P[BASE + 4], P[BASE + 5]), b1 = cvt_pk_bf16(P[BASE + 6], P[BASE + 7]);                              \
    auto r0 = __builtin_amdgcn_permlane32_swap(a0, b0, false, false); auto r1 = __builtin_amdgcn_permlane32_swap(a1, b1, false, false); \
    u32x4 w = {r0[0], r1[0], r0[1], r1[1]}; OUT = *reinterpret_cast<bf16x8*>(&w); } while (0)
    PK4(p0, 0, pa0); PK4(p0, 8, pa1);
#undef PK4
}
__device__ __forceinline__ void qkt(f32x16& p0, const char* Ks, const bf16x8* qr, const int* ko) {
    p0 = f32x16{};
#define KFR(d0) (*reinterpret_cast<const bf16x8*>(Ks + ko[(d0) & 3] + ((d0) >> 2) * 128))
    bf16x8 k0 = KFR(0), k1 = KFR(1);
#pragma unroll
    for (int g = 0; g < 4; ++g) {
        bf16x8 nk0 = k0, nk1 = k1;
        if (g < 3) { nk0 = KFR(2 * g + 2); nk1 = KFR(2 * g + 3); }
        SBAR(); __builtin_amdgcn_s_setprio(1);
        p0 = __builtin_amdgcn_mfma_f32_32x32x16_bf16(k0, qr[2 * g], p0, 0, 0, 0);
        p0 = __builtin_amdgcn_mfma_f32_32x32x16_bf16(k1, qr[2 * g + 1], p0, 0, 0, 0);
        __builtin_amdgcn_s_setprio(0); SBAR();
        k0 = nk0; k1 = nk1;
    }
#undef KFR
}
__device__ __forceinline__ int v_st(int k, int c) { const int kk = (k & ~0xC) | ((k & 4) << 1) | ((k & 8) >> 1); return ((kk >> 3) * 8 + (c >> 5)) * 512 + ((kk & 7) * 32 + (c & 31)) * 2; }
__device__ __forceinline__ int v_rd_base(int lane) { return ((lane & 3) << 3) | (((lane >> 2) & 3) << 6) | (((lane >> 4) & 1) << 5) | (((lane >> 5) & 1) << 8); }
constexpr int v_rd_off(int d0, int ks, int half) { return d0 * 512 + ks * 8192 + half * 4096; }
template <int OFF> __device__ __forceinline__ s16x4 tr_read(int vb) {
    s16x4 r; asm volatile("ds_read_b64_tr_b16 %0, %1 offset:%2" : "=&v"(r) : "v"(vb), "i"(OFF) : "memory"); return r;
}
struct VFrag { s16x4 l0, h0, l1, h1; };
template <int D0> __device__ __forceinline__ VFrag v_read(int vb) {
    VFrag f; f.l0 = tr_read<v_rd_off(D0, 0, 0)>(vb); f.h0 = tr_read<v_rd_off(D0, 0, 1)>(vb); f.l1 = tr_read<v_rd_off(D0, 1, 0)>(vb); f.h1 = tr_read<v_rd_off(D0, 1, 1)>(vb); return f;
}
#define PK(L, H) (bf16x8){L[0], L[1], L[2], L[3], H[0], H[1], H[2], H[3]}
#define PV_STEP(D0, CUR, NXT, WAITN) do { if ((D0) < 7) NXT = v_read<((D0) < 7 ? (D0) + 1 : 7)>(vb); \
    asm volatile("s_waitcnt lgkmcnt(" #WAITN ")" ::: "memory"); SBAR(); __builtin_amdgcn_s_setprio(1); \
    o[D0] = __builtin_amdgcn_mfma_f32_32x32x16_bf16(pa0, PK(CUR.l0, CUR.h0), o[D0], 0, 0, 0); \
    o[D0] = __builtin_amdgcn_mfma_f32_32x32x16_bf16(pa1, PK(CUR.l1, CUR.h1), o[D0], 0, 0, 0); __builtin_amdgcn_s_setprio(0); SBAR(); } while (0)
__device__ __forceinline__ void pv_all(f32x16* o, int vb, bf16x8 pa0, bf16x8 pa1) {
    asm volatile("s_waitcnt lgkmcnt(0)" ::: "memory");
    VFrag fa = v_read<0>(vb), fb;
    PV_STEP(0, fa, fb, 4); PV_STEP(1, fb, fa, 4); PV_STEP(2, fa, fb, 4); PV_STEP(3, fb, fa, 4);
    PV_STEP(4, fa, fb, 4); PV_STEP(5, fb, fa, 4); PV_STEP(6, fa, fb, 4); PV_STEP(7, fb, fa, 0);
}
#undef PV_STEP
#undef PK

__device__ __forceinline__ void attn_pass(const bf16_t* __restrict__ Qb, const bf16_t* __restrict__ Kh, const bf16_t* __restrict__ Vh,
                                          float* Ob, int seq, char* lds, int mode, float lam, const LAS float* tab, float cL, float cR, int q0) {
    const int tid0 = threadIdx.x, wid = __builtin_amdgcn_readfirstlane(tid0 >> 6);
    char* V_lds = lds + OFF_V; char* K_lds = lds + OFF_K;
    float* wsl = (float*)(lds + OFF_W) + wid * 64; float* li_l = wsl; float* al_l = wsl + 32;
    float m_reg = -1e30f, l_reg = 0; f32x16 o[8] = {};
    struct Stg { bf16x8 vs0, vs1, ks0; } stA, stB;
#define SLOADX(ST, k0) do { const int sr = tq >> 4, sc = (tq & 15) * 8; const bf16_t* vp = Vh + (long)((k0) + sr) * LDK + sc; const bf16_t* kp = Kh + (long)((k0) + sr) * LDK + sc; \
    ST.vs0 = *reinterpret_cast<const bf16x8*>(vp); ST.vs1 = *reinterpret_cast<const bf16x8*>(vp + 128); ST.ks0 = *reinterpret_cast<const bf16x8*>(kp); } while (0)
#define SWRITEX(ST, b) do { const int sr = tq >> 4, sc = (tq & 15) * 8; \
    *(bf16x8*)(V_lds + (b) * SHM_V + v_st(sr, sc)) = ST.vs0; *(bf16x8*)(V_lds + (b) * SHM_V + v_st(sr, sc + 128)) = ST.vs1; \
    *(bf16x8*)(K_lds + (b) * SHM_K + KSWZ(sr, sc * 2)) = ST.ks0; } while (0)
    const int NT = seq / KVBLK;
    bf16x8 qr[8];
    { int tq = tid0; asm volatile("" : "+v"(tq)); SLOADX(stA, 0); SLOADX(stB, KVBLK);
      const int lane = tq & 63, r32 = lane & 31, hi = lane >> 5;
      const bf16_t* Qw = Qb + (long)(wid * QBLK + r32) * LDQ + hi * 8;
#pragma unroll
      for (int d0 = 0; d0 < 8; ++d0) qr[d0] = *reinterpret_cast<const bf16x8*>(Qw + d0 * 16);
      SWRITEX(stA, 0); SWRITEX(stB, 1); if (2 < NT) SLOADX(stA, 2 * KVBLK); }
    asm volatile("" :: "v"(qr[0]), "v"(qr[1]), "v"(qr[2]), "v"(qr[3]), "v"(qr[4]), "v"(qr[5]), "v"(qr[6]), "v"(qr[7]));
    __syncthreads();
    int ko[4];
    { int tq = tid0; asm volatile("" : "+v"(tq)); const int lane = tq & 63, r32 = lane & 31, hi = lane >> 5, rsw = (r32 & 7) << 4;
#pragma unroll
      for (int i = 0; i < 4; ++i) ko[i] = r32 * 256 + ((((i * 16 + hi * 8) * 2)) ^ rsw);
    }
#define TILE_BODY(J, STW, STL) do { \
        int tq = tid0; asm volatile("" : "+v"(tq)); \
        const int lane = tq & 63, r32 = lane & 31, hi = lane >> 5; \
        const int b = (J) & 1; \
        f32x16 p0; float alpha; bf16x8 pa0, pa1; \
        SLOADX(STL, (((J) + 3 < NT) ? (J) + 3 : NT - 1) * KVBLK);     \
        qkt(p0, K_lds + b * SHM_K, qr, ko); \
        BiasCtx B; B.tab = tab; B.cL = cL; B.cR = cR; B.qlo = q0 + wid * QBLK; B.qrow = B.qlo + r32; B.hi = hi; \
        softmax_tile(p0, m_reg, l_reg, alpha, (J) * KVBLK, B, pa0, pa1); \
        if (__any(alpha < 1.f)) { if (hi == 0) al_l[r32] = alpha; asm volatile("s_waitcnt lgkmcnt(0)" ::: "memory"); \
            _Pragma("unroll") for (int r = 0; r < 16; ++r) { const float av = al_l[crow(r, hi)]; \
                _Pragma("unroll") for (int d = 0; d < 8; ++d) o[d][r] *= av; } } \
        pv_all(o, (int)(uintptr_t)V_lds + b * SHM_V + v_rd_base(lane), pa0, pa1); \
        asm volatile("s_waitcnt lgkmcnt(0)" ::: "memory"); __builtin_amdgcn_s_barrier(); asm volatile("" ::: "memory");     \
        SWRITEX(STW, b); } while (0)
#pragma unroll 1
    for (int j = 0; j < NT; j += 2) { TILE_BODY(j, stA, stB); TILE_BODY(j + 1, stB, stA); }
#undef TILE_BODY
    {
        int tq = tid0; asm volatile("" : "+v"(tq));
        const int lane = tq & 63, r32 = lane & 31, hi = lane >> 5;
        if (hi == 0) li_l[r32] = l_reg; asm volatile("s_waitcnt lgkmcnt(0)" ::: "memory");
        float* Ow = Ob + (long)(wid * QBLK + 4 * hi) * LDO + r32;
        if (mode == 0) {
#pragma unroll
            for (int r = 0; r < 16; ++r) { float* a = Ow + ((r & 3) + 8 * (r >> 2)) * LDO; const float rl = __builtin_amdgcn_rcpf(li_l[crow(r, hi)]);
#pragma unroll
                for (int d0 = 0; d0 < 8; ++d0) a[d0 * 32] = o[d0][r] * rl;
                SBAR(); }
        } else {
#pragma unroll
            for (int rg = 0; rg < 4; ++rg) {
                float prev[4][8];
#pragma unroll
                for (int rr = 0; rr < 4; ++rr) { const float* a = Ow + (rr + 8 * rg) * LDO;
#pragma unroll
                    for (int d0 = 0; d0 < 8; ++d0) prev[rr][d0] = a[d0 * 32]; }
#pragma unroll
                for (int rr = 0; rr < 4; ++rr) { const int r = 4 * rg + rr; float* a = Ow + (rr + 8 * rg) * LDO; const float rl = __builtin_amdgcn_rcpf(li_l[crow(r, hi)]);
#pragma unroll
                    for (int d0 = 0; d0 < 8; ++d0) a[d0 * 32] = prev[rr][d0] - lam * (o[d0][r] * rl); }
                SBAR(); }
        }
    }
#undef SLOADX
#undef SWRITEX
}
}

constexpr int SC_BROW = 528;
constexpr int SC_CHAIN_LDS = 16 * SC_BROW;
constexpr int SC_WAVE_LDS = 2 * SC_CHAIN_LDS;
__device__ __forceinline__ void scan_wave(const Params& p, char* ldsw, int tok0, int L, int g, int lane) {
    bf16_t* P = (bf16_t*)(p.ws + WS_P);
    float* YF = (float*)((char*)p.out + DO_YF);
    asm volatile("" : "+v"(lane));
    const int fr = lane & 15, fq = lane >> 4, n = lane;
    const float dsk = p.in[14][g * 16 + fr];
    float ar[2], ai[2]; bf16x8 af[2][8], cf[2][4];
#pragma unroll
    for (int dir = 0; dir < 2; ++dir) {
        const int dg = dir * 64 + g;
        const float lre = p.in[7][dg * 64 + n], lim = p.in[8][dg * 64 + n], dt = expf(p.in[9][dg]);
        const float mag = expf(lre * dt); ar[dir] = mag * cosf(lim * dt); ai[dir] = mag * sinf(lim * dt);
        const float den = lre * lre + lim * lim, nr = ar[dir] - 1.0f, ni = ai[dir];
        const float kre = (nr * lre + ni * lim) / den, kim = (ni * lre - nr * lim) / den;
#pragma unroll
        for (int q = 0; q < 8; ++q) {
            const int nq = 8 * q + (fr >> 1); const float kr = __shfl(kre, nq), ki = __shfl(kim, nq);
            u32x4 w = {0u, 0u, 0u, 0u};
            if (fq < 2) {
                const float* br = p.in[10] + ((size_t)dg * 64 + nq) * 16 + 8 * fq; const float* bi = p.in[11] + ((size_t)dg * 64 + nq) * 16 + 8 * fq;
                const f32x4 r0 = *(const f32x4*)br, r1 = *(const f32x4*)(br + 4), i0 = *(const f32x4*)bi, i1 = *(const f32x4*)(bi + 4);
                f32x4 v0, v1;
                if (fr & 1) { v0 = kr * i0 + ki * r0; v1 = kr * i1 + ki * r1; } else { v0 = kr * r0 - ki * i0; v1 = kr * r1 - ki * i1; }
                w.x = cvt_pk_bf16(v0[0], v0[1]); w.y = cvt_pk_bf16(v0[2], v0[3]); w.z = cvt_pk_bf16(v1[0], v1[1]); w.w = cvt_pk_bf16(v1[2], v1[3]);
            }
            af[dir][q] = *reinterpret_cast<bf16x8*>(&w);
        }
        const float* cre = p.in[12] + ((size_t)dg * 16 + fr) * 64; const float* cim = p.in[13] + ((size_t)dg * 16 + fr) * 64;
#pragma unroll
        for (int s = 0; s < 4; ++s) { u32x4 w; unsigned ww[4];
#pragma unroll
            for (int jj = 0; jj < 4; ++jj) { const int nn = 16 * s + 4 * fq + jj; ww[jj] = cvt_pk_bf16(cre[nn], -cim[nn]); }
            w.x = ww[0]; w.y = ww[1]; w.z = ww[2]; w.w = ww[3]; cf[dir][s] = *reinterpret_cast<bf16x8*>(&w); }
    }
    float hr[2] = {0.f, 0.f}, hi_[2] = {0.f, 0.f};
    const int nblk = L / 16, half = nblk / 2;
    const bf16_t* ubase = P + (size_t)(tok0 + fr) * INW + COL_SX + g * 16 + 8 * (fq & 1);
    u32x4 ureg[2] = {{0u, 0u, 0u, 0u}, {0u, 0u, 0u, 0u}};
    if (fq < 2) { ureg[0] = *(const u32x4*)(ubase); ureg[1] = *(const u32x4*)(ubase + (size_t)((nblk - 1) * 16) * INW); }
    for (int i = 0; i < nblk; ++i) {
        const int blk[2] = {i, nblk - 1 - i}; const bool second = (i >= half), hasn = (i + 1 < nblk);
        bf16x8 uf[2]; uf[0] = *reinterpret_cast<bf16x8*>(&ureg[0]); uf[1] = *reinterpret_cast<bf16x8*>(&ureg[1]);
        if (hasn && fq < 2) { ureg[0] = *(const u32x4*)(ubase + (size_t)((i + 1) * 16) * INW); ureg[1] = *(const u32x4*)(ubase + (size_t)((nblk - 2 - i) * 16) * INW); }
        f32x4 acc[2]; size_t orow[2];
#pragma unroll
        for (int d = 0; d < 2; ++d) { acc[d] = (f32x4){0.f, 0.f, 0.f, 0.f}; orow[d] = (size_t)(tok0 + blk[d] * 16 + fq * 4);
            if (second) {
#pragma unroll
                for (int j = 0; j < 4; ++j) acc[d][j] = YF[(orow[d] + j) * 1024 + g * 16 + fr] + dsk * __uint_as_float((unsigned)P[(orow[d] + j) * INW + COL_SX + g * 16 + fr] << 16);
            } }
#pragma unroll
        for (int d = 0; d < 2; ++d)
#pragma unroll
            for (int q = 0; q < 8; ++q) {
                const f32x4 dd = __builtin_amdgcn_mfma_f32_16x16x32_bf16(af[d][q], uf[d], (f32x4){0.f, 0.f, 0.f, 0.f}, 0, 0, 0);
                *(f32x4*)(ldsw + d * SC_CHAIN_LDS + fr * SC_BROW + (16 * q + 4 * fq) * 4) = dd;
            }
        __builtin_amdgcn_wave_barrier(); asm volatile("s_waitcnt lgkmcnt(0)" ::: "memory");
#pragma unroll 4
        for (int s = 0; s < 16; ++s) {
            char* r0 = ldsw + s * SC_BROW; char* r1 = ldsw + SC_CHAIN_LDS + (15 - s) * SC_BROW;
            const f32x2 b0 = *(const f32x2*)(r0 + n * 8), b1 = *(const f32x2*)(r1 + n * 8);
            const float f_r = fmaf(ar[0], hr[0], fmaf(-ai[0], hi_[0], b0[0])), f_i = fmaf(ar[0], hi_[0], fmaf(ai[0], hr[0], b0[1]));
            const float g_r = fmaf(ar[1], hr[1], fmaf(-ai[1], hi_[1], b1[0])), g_i = fmaf(ar[1], hi_[1], fmaf(ai[1], hr[1], b1[1]));
            hr[0] = f_r; hi_[0] = f_i; hr[1] = g_r; hi_[1] = g_i;
            *(unsigned*)(r0 + n * 4) = cvt_pk_bf16(f_r, f_i);
            *(unsigned*)(r1 + n * 4) = cvt_pk_bf16(g_r, g_i);
        }
        __builtin_amdgcn_wave_barrier(); asm volatile("s_waitcnt lgkmcnt(0)" ::: "memory");
#pragma unroll
        for (int s = 0; s < 4; ++s)
#pragma unroll
            for (int d = 0; d < 2; ++d) { const bf16x8 a = *(const bf16x8*)(ldsw + d * SC_CHAIN_LDS + fr * SC_BROW + (32 * s + 8 * fq) * 2);
                acc[d] = __builtin_amdgcn_mfma_f32_16x16x32_bf16(a, cf[d][s], acc[d], 0, 0, 0); }
#pragma unroll
        for (int d = 0; d < 2; ++d) {
            if (!second) {
#pragma unroll
                for (int j = 0; j < 4; ++j) YF[(orow[d] + j) * 1024 + g * 16 + fr] = acc[d][j];
            } else {
#pragma unroll
                for (int j = 0; j < 4; ++j) P[(orow[d] + j) * INW + COL_SX + g * 16 + fr] = (bf16_t)(cvt_pk_bf16(gelu_tanh(acc[d][j]), 0.f) & 0xffffu);
            } }
        __builtin_amdgcn_wave_barrier(); asm volatile("" ::: "memory");
    }
}

static_assert(8 * SC_WAVE_LDS <= 147456, "scan LDS");
__device__ __forceinline__ void transpose_cvt(const float* __restrict__ W, int K, int N, const float* __restrict__ rs, bf16_t* __restrict__ dst, float* tile  , int wg, int nwg) {
    const int tid = threadIdx.x, nkt = K / 64, nnt = N / 64, ntile = nkt * nnt;
    const int lk = tid >> 3, lseg = (tid & 7) * 8;
    for (int t = wg; t < ntile; t += nwg) {
        const int kt = t / nnt, ntl = t % nnt, k0 = kt * 64, n0 = ntl * 64;
        const float* src = W + (size_t)(k0 + lk) * N + n0 + lseg;
        const f32x4 a = *(const f32x4*)src, b = *(const f32x4*)(src + 4);
        float* tr = tile + lk * 65 + lseg;
        tr[0] = a[0]; tr[1] = a[1]; tr[2] = a[2]; tr[3] = a[3]; tr[4] = b[0]; tr[5] = b[1]; tr[6] = b[2]; tr[7] = b[3];
        __syncthreads();
        float v[8];
#pragma unroll
        for (int j = 0; j < 8; ++j) { v[j] = tile[(lseg + j) * 65 + lk]; if (rs) v[j] *= rs[k0 + lseg + j]; }
        u32x4 w; w.x = cvt_pk_bf16(v[0], v[1]); w.y = cvt_pk_bf16(v[2], v[3]); w.z = cvt_pk_bf16(v[4], v[5]); w.w = cvt_pk_bf16(v[6], v[7]);
        *(u32x4*)(dst + (size_t)(n0 + lk) * K + k0 + lseg) = w;
        __syncthreads();
    }
}
__device__ __forceinline__ int rel_bucket_dev(int rel) {
    const int n = rel < 0 ? -rel : rel;
    const int large = 8 + (n >= 12) + (n >= 16) + (n >= 23) + (n >= 32) + (n >= 46) + (n >= 64) + (n >= 91);
    return (rel > 0 ? 16 : 0) + (n < 8 ? n : large);
}


#define XB_TMO      128
#define XB_XCNT(j)  (256  + 64 * (j))
#define XB_XSUB(j)  (1280 + 64 * (j))
#define XB_XGEN(j)  (2304 + 64 * (j))
#define XB_TOP      3328
#define XB_TOPGEN   3392
#define XCD_BAR_WORDS 3456
#define XB_SPIN_CAP (1u << 22)
__device__ __forceinline__ unsigned xb_ld(unsigned* p)              { return __hip_atomic_load(p, __ATOMIC_RELAXED, __HIP_MEMORY_SCOPE_AGENT); }
__device__ __forceinline__ unsigned xb_add(unsigned* p, unsigned v) { return __hip_atomic_fetch_add(p, v, __ATOMIC_RELAXED, __HIP_MEMORY_SCOPE_AGENT); }
__device__ __forceinline__ unsigned xb_xcc_id() { return (unsigned)__builtin_amdgcn_s_getreg((3 << 11) | 20) & 0xFu; }
#define XB_SPIN(cond, bar) do { unsigned _sp = 0; while (cond) { __builtin_amdgcn_s_sleep(1); \
    if ((++_sp & 255u) == 0u) { if (xb_ld(&(bar)[XB_TMO])) break; if (_sp > XB_SPIN_CAP) { atomicAdd(&(bar)[XB_TMO], 1u); break; } } } } while (0)
struct XcdBarrier { unsigned* bar; unsigned x; volatile LAS unsigned* st; };
__device__ __forceinline__ XcdBarrier xcd_barrier_post(unsigned* bar, volatile LAS unsigned* st) {
    XcdBarrier b; b.bar = bar; b.x = xb_xcc_id(); b.st = st;
    if (threadIdx.x == 0) (void)xb_add(&bar[XB_XCNT(b.x)], 1u);
    return b;
}
__device__ __forceinline__ void xcd_barrier_complete(unsigned* bar, unsigned x, unsigned& nloc, unsigned& nx) {
    const unsigned G = gridDim.x * gridDim.y * gridDim.z;
    unsigned sum, cnt, mine, sp = 0u;
    for (;;) {
        sum = 0u; cnt = 0u; mine = 0u;
#pragma unroll
        for (unsigned j = 0; j < 16; ++j) { const unsigned c = xb_ld(&bar[XB_XCNT(j)]); sum += c; cnt += (c > 0u) ? 1u : 0u; mine = (j == x) ? c : mine; }
        if (sum == G) break;
        __builtin_amdgcn_s_sleep(1);
        if ((++sp & 255u) == 0u) { if (xb_ld(&bar[XB_TMO])) break; if (sp > XB_SPIN_CAP) { atomicAdd(&bar[XB_TMO], 1u); break; } }
    }
    nloc = mine > 0u ? mine : 1u; nx = cnt > 0u ? cnt : 1u;
}
__device__ __forceinline__ void xcd_barrier(const XcdBarrier& b) {
    asm volatile("s_waitcnt vmcnt(0)" ::: "memory");
    __syncthreads();
    if (threadIdx.x == 0) {
        unsigned* bar = b.bar;
        __builtin_amdgcn_s_waitcnt(0);
        unsigned nloc = b.st[0], nx = b.st[1];
        if (nloc == 0u) { xcd_barrier_complete(bar, b.x, nloc, nx); b.st[0] = nloc; b.st[1] = nx; }
        const unsigned old = xb_add(&bar[XB_XSUB(b.x)], 1u);
        const unsigned gen = old / nloc;
        if (old + 1u == (gen + 1u) * nloc) {
            __builtin_amdgcn_fence(__ATOMIC_RELEASE, "agent");
            asm volatile("s_waitcnt vmcnt(0)" ::: "memory");
            const unsigned og = xb_add(&bar[XB_TOP], 1u);
            const unsigned tg = og / nx;
            if (og + 1u == (tg + 1u) * nx) xb_add(&bar[XB_TOPGEN], 1u);
            else XB_SPIN(xb_ld(&bar[XB_TOPGEN]) == tg, bar);
            __builtin_amdgcn_fence(__ATOMIC_ACQUIRE, "agent");
            xb_add(&bar[XB_XGEN(b.x)], 1u);
            asm volatile("s_waitcnt vmcnt(0)" ::: "memory");
        } else {
            XB_SPIN(xb_ld(&bar[XB_XGEN(b.x)]) == gen, bar);
            __builtin_amdgcn_fence(__ATOMIC_ACQUIRE, "agent");
            asm volatile("s_waitcnt vmcnt(0)" ::: "memory");
        }
    }
    __syncthreads();
}

#ifndef PH_0
#define PH_0 1
#define PH_1 1
#define PH_2 1
#define PH_3 1
#define PH_4 1
#define PH_5 1
#define PH_6 1
#endif
constexpr int LDS_MISC = 147456;
constexpr int LDS_BYTES = LDS_MISC + 64;
__global__ void __launch_bounds__(512, 2) hybrid_fwd(Params p) {
    extern __shared__ __attribute__((aligned(16))) unsigned char lds[];
    cg::grid_group grid = cg::this_grid();
    const int tid = threadIdx.x, lane = tid & 63, wid = __builtin_amdgcn_readfirstlane(tid >> 6);
    const int G = gridDim.x, bx = blockIdx.x;
    unsigned char* ws = p.ws;
    bf16_t* P = (bf16_t*)(ws + WS_P);
    bf16_t* XB = (bf16_t*)((char*)p.out + DO_XB); bf16_t* WIN = (bf16_t*)((char*)p.out + DO_WIN);
    bf16_t* Y2 = (bf16_t*)((char*)p.out + DO_Y2); float* OSC = (float*)((char*)p.out + DO_OSC);
    bf16_t* WGLU = (bf16_t*)(ws + WS_WGLU); bf16_t* WBS = (bf16_t*)(ws + WS_WBS); bf16_t* WBA = (bf16_t*)(ws + WS_WBA);
    bf16_t* WOUT = (bf16_t*)(ws + WS_WOUT); bf16_t* WPG = (bf16_t*)(ws + WS_WPG); bf16_t* WPP = (bf16_t*)(ws + WS_WPP);
    bf16_t* PB = (bf16_t*)(ws + WS_PB);
    float* rstd1 = (float*)(ws + WS_RSTD1); float* ss2 = (float*)(ws + WS_SS2); float* ss3 = (float*)(ws + WS_SS3);
    float* biasw = (float*)(ws + WS_BIAS); float* misc = (float*)(ws + WS_MISC); unsigned* qctr = (unsigned*)(ws + WS_MISC + 64);
    LAS unsigned char* ldsl = (LAS unsigned char*)lds;
    if (tid == 0) { *(volatile LAS unsigned*)(ldsl + LDS_MISC + 16) = 0u; *(volatile LAS unsigned*)(ldsl + LDS_MISC + 20) = 0u; }
    __syncthreads();
    XcdBarrier xbar = xcd_barrier_post((unsigned*)(ws + WS_BAR), (volatile LAS unsigned*)(ldsl + LDS_MISC + 16));

#if PH_0
    {
        float* tile = (float*)lds;
        transpose_cvt(p.in[6], DM, INW, p.in[5], WIN, tile, bx, G);
        for (int row = bx * 8 + wid; row < T_ALL; row += G * 8) {
            const float* xr = (row < T_P) ? p.in[0] + (size_t)row * DM : p.in[1] + (size_t)(row - T_P) * DM;
            f32x4 xa[4], xb_[4]; float s = 0.f;
#pragma unroll
            for (int i = 0; i < 4; ++i) { const int c = (i * 64 + lane) * 8; xa[i] = *(const f32x4*)(xr + c); xb_[i] = *(const f32x4*)(xr + c + 4); }
#pragma unroll
            for (int i = 0; i < 4; ++i) { const f32x4 a = xa[i], b = xb_[i];
                s += (a[0] * a[0] + a[1] * a[1]) + (a[2] * a[2] + a[3] * a[3]) + (b[0] * b[0] + b[1] * b[1]) + (b[2] * b[2] + b[3] * b[3]); }
            s = wave_sum(s);
            const float rs = 1.0f / sqrtf(s * (1.0f / DM) + EPS);
#pragma unroll
            for (int i = 0; i < 4; ++i) { const int c = (i * 64 + lane) * 8; const f32x4 a = xa[i] * rs, b = xb_[i] * rs;
                u32x4 w; w.x = cvt_pk_bf16(a[0], a[1]); w.y = cvt_pk_bf16(a[2], a[3]); w.z = cvt_pk_bf16(b[0], b[1]); w.w = cvt_pk_bf16(b[2], b[3]);
                *(u32x4*)(XB + (size_t)row * DM + c) = w; }
        }
        for (int i = bx * 512 + tid; i < T_ALL; i += G * 512) { ss2[i] = 0.f; ss3[i] = 0.f; }
        if (bx == 0) {
            for (int i = tid; i < 4 * 384; i += 512) { const int h = i / 384, rel = (i % 384) - 192; biasw[i] = p.in[4][rel_bucket_dev(rel) * 4 + h] * LOG2E; }
            if (wid == 0) {
                float a = p.in[17][lane] * p.in[18][lane] + p.in[17][lane + 64] * p.in[18][lane + 64];
                float b = p.in[19][lane] * p.in[20][lane] + p.in[19][lane + 64] * p.in[20][lane + 64];
                a = wave_sum(a); b = wave_sum(b);
                if (lane == 0) { misc[0] = expf(a) - expf(b) + 0.2f; qctr[0] = 0u; qctr[1] = 0u; qctr[2] = 0u; }
            }
        }
    }
#endif
    grid.sync();
#if PH_1
    {
        pg8::Gemm g{XB, DM, WIN, T_ALL, INW, DM}; pg8::StaticOrder S; S.init(T_ALL, INW, G, bx);
        EpiG1 E{P, rstd1};
        pg8::gemm_phase<EpiG1>(ldsl, g, S, E);
    }
#endif
    xcd_barrier(xbar);
#if PH_2
    {
        for (;;) {
            __syncthreads();
            if (tid == 0) *(volatile int*)(lds + LDS_MISC) = (int)atomicAdd(qctr, 1u);
            __syncthreads();
            const int item = __builtin_amdgcn_readfirstlane(*(volatile int*)(lds + LDS_MISC));
            if (item >= 160) break;
            int seq, gq, tok0, L;
            if (item < 32) { seq = item >> 3; gq = item & 7; tok0 = seq * 4096; L = 4096; }
            else { const int it = item - 32; seq = it >> 3; gq = it & 7; tok0 = T_P + seq * 2048; L = 2048; }
            scan_wave(p, (char*)lds + wid * SC_WAVE_LDS, tok0, L, gq * 8 + wid, lane);
        }
        const float lam = __uint_as_float(__builtin_amdgcn_readfirstlane(__float_as_uint(misc[0])));
        for (;;) {
            __syncthreads();
            if (tid == 0) *(volatile int*)(lds + LDS_MISC) = (int)atomicAdd(qctr + 1, 1u);
            __syncthreads();
            const int item = __builtin_amdgcn_readfirstlane(*(volatile int*)(lds + LDS_MISC));
            if (item >= 768) break;
            int b, h, qb, tok0, L;
            if (item < 256) { b = item >> 6; h = (item >> 4) & 3; qb = item & 15; L = 4096; tok0 = b * 4096; }
            else { const int it = item - 256; b = it >> 5; h = (it >> 3) & 3; qb = it & 7; L = 2048; tok0 = T_P + b * 2048; }
            LAS float* tab = (LAS float*)(ldsl + att::OFF_TAB);
            if (tid < 384) tab[tid] = biasw[h * 384 + tid];
            const float cL = __uint_as_float(__builtin_amdgcn_readfirstlane(__float_as_uint(biasw[h * 384 + 0]))), cR = __uint_as_float(__builtin_amdgcn_readfirstlane(__float_as_uint(biasw[h * 384 + 383])));
            const int q0 = qb * 256;
            const bf16_t* Pq = P + (size_t)(tok0 + q0) * INW;
            const bf16_t* Ps = P + (size_t)tok0 * INW;
            float* Ob = OSC + (size_t)(tok0 + q0) * 1024 + h * 256;
#pragma unroll 1
            for (int pass = 0; pass < 2; ++pass) {
                __syncthreads();
                att::attn_pass(Pq + COL_Q + h * 256 + pass * 128, Ps + COL_K + h * 256 + pass * 128, Ps + COL_V + h * 256,
                               Ob, L, (char*)lds, pass, lam, tab, cL, cR, q0);
            }
            __builtin_amdgcn_fence(__ATOMIC_RELEASE, "agent");
            __syncthreads();
            __builtin_amdgcn_fence(__ATOMIC_ACQUIRE, "agent");
            int ln = lane; asm volatile("" : "+v"(ln));
            const f32x4 sg = *(const f32x4*)(p.in[21] + ln * 4);
            for (int rb = wid; rb < 256; rb += 64) {
                f32x4 vv[8]; u32x2 azz[8];
#pragma unroll
                for (int k = 0; k < 8; ++k) { const size_t tok = (size_t)(tok0 + q0 + rb + 8 * k);
                    vv[k] = *(const f32x4*)(OSC + tok * 1024 + h * 256 + ln * 4); azz[k] = *(const u32x2*)(P + tok * INW + COL_AZ + h * 256 + ln * 4); }
#pragma unroll
                for (int k = 0; k < 8; ++k) { const size_t tok = (size_t)(tok0 + q0 + rb + 8 * k); const f32x4 v = vv[k]; const u32x2 az = azz[k];
                    float s = (v[0] * v[0] + v[1] * v[1]) + (v[2] * v[2] + v[3] * v[3]); s = wave_sum(s);
                    const float rs = 0.8f / sqrtf(s * (1.0f / 256.0f) + EPS);
                    u32x2 w; w.x = cvt_pk_bf16(v[0] * rs * sg[0] * bf_lo(az.x), v[1] * rs * sg[1] * bf_hi(az.x));
                    w.y = cvt_pk_bf16(v[2] * rs * sg[2] * bf_lo(az.y), v[3] * rs * sg[3] * bf_hi(az.y));
                    *(u32x2*)(P + tok * INW + COL_Q + h * 256 + ln * 4) = w; }
            }
        }
            for (;;) {
            __syncthreads();
            if (tid == 0) *(volatile int*)(lds + LDS_MISC) = (int)atomicAdd(qctr + 2, 1u);
            __syncthreads();
            const int it = __builtin_amdgcn_readfirstlane(*(volatile int*)(lds + LDS_MISC));
            if (it >= 1632) break;
            float* tile = (float*)lds;
            if (it < 64) transpose_cvt(p.in[15], 1024, 1024, nullptr, WGLU, tile, it, 64);
            else if (it < 192) transpose_cvt(p.in[22], 1024, DM, nullptr, WBS, tile, it - 64, 128);
            else if (it < 320) transpose_cvt(p.in[23], 1024, DM, nullptr, WBA, tile, it - 192, 128);
            else if (it < 576) transpose_cvt(p.in[24], DM, DM, nullptr, WOUT, tile, it - 320, 256);
            else if (it < 832) transpose_cvt(p.in[26], DM, DM, p.in[25], WPG, tile, it - 576, 256);
            else if (it < 864) transpose_cvt(p.in[27], PLE, DM, nullptr, WPP, tile, it - 832, 32);
            else {
                const size_t base = (size_t)(it - 864) * 16384;
#pragma unroll
                for (int k = 0; k < 4; ++k) { const size_t e = base + ((size_t)k * 512 + tid) * 8; const float* src = (e < (size_t)T_P * PLE) ? p.in[2] + e : p.in[3] + (e - (size_t)T_P * PLE);
                    const f32x4 a = *(const f32x4*)src, b = *(const f32x4*)(src + 4);
                    u32x4 w; w.x = cvt_pk_bf16(a[0], a[1]); w.y = cvt_pk_bf16(a[2], a[3]); w.z = cvt_pk_bf16(b[0], b[1]); w.w = cvt_pk_bf16(b[2], b[3]);
                    *(u32x4*)(PB + e) = w; }
            }
        }
    }
#endif
    xcd_barrier(xbar);
#if PH_3
    {
        pg8::Gemm g{P + COL_SX, INW, WGLU, T_ALL, 1024, 1024}; pg8::StaticOrder S; S.init(T_ALL, 1024, G, bx);
        EpiD1 E{P, p.in[16], Y2};
        pg8::gemm_phase<EpiD1>(ldsl, g, S, E);
    }
    {
        pg8::Gemm g{PB, PLE, WPP, T_ALL, DM, PLE}; pg8::StaticOrder S; S.init(T_ALL, DM, G, bx);
        EpiGate<2> E{P};
        pg8::gemm_phase<EpiGate<2>>(ldsl, g, S, E);
    }
#endif
    xcd_barrier(xbar);
#if PH_4
    {
        pg8::Gemm g{Y2, 1024, WBS, T_ALL, DM, 1024}; pg8::StaticOrder S; S.init(T_ALL, DM, G, bx);
        EpiGate<0> E{P};
        pg8::gemm_phase<EpiGate<0>>(ldsl, g, S, E);
    }
    {
        pg8::Gemm g{P + COL_Q, INW, WBA, T_ALL, DM, 1024}; pg8::StaticOrder S; S.init(T_ALL, DM, G, bx);
        EpiGate<1> E{P};
        pg8::gemm_phase<EpiGate<1>>(ldsl, g, S, E);
    }
#endif
    xcd_barrier(xbar);
#if PH_5
    {
        pg8::Gemm g{P + COL_GS, INW, WOUT, T_ALL, DM, DM}; pg8::StaticOrder S; S.init(T_ALL, DM, G, bx);
        EpiD3 E{p.in[0], p.in[1], P, ss2};
        pg8::gemm_phase<EpiD3>(ldsl, g, S, E);
    }
#endif
    xcd_barrier(xbar);
#if PH_6
    {
        pg8::Gemm g{P + COL_HB, INW, WPG, T_ALL, DM, DM}; pg8::StaticOrder S; S.init(T_ALL, DM, G, bx);
        EpiD4 E{P, ss2, ss3};
        pg8::gemm_phase<EpiD4>(ldsl, g, S, E);
    }
#endif
    xcd_barrier(xbar);
    for (int row = (bx * 8 + wid) * 2; row < T_ALL; row += G * 16) {
        u32x4 hw[2][4]; float ssv[2];
#pragma unroll
        for (int rr = 0; rr < 2; ++rr) { ssv[rr] = ss3[row + rr]; const bf16_t* hrow = P + (size_t)(row + rr) * INW + COL_H2;
#pragma unroll
            for (int i = 0; i < 4; ++i) hw[rr][i] = *(const u32x4*)(hrow + (i * 64 + lane) * 8); }
#pragma unroll
        for (int rr = 0; rr < 2; ++rr) { const float rs = 1.0f / sqrtf(ssv[rr] * (1.0f / DM) + EPS); float* o = p.out + (size_t)(row + rr) * DM;
#pragma unroll
            for (int i = 0; i < 4; ++i) { const int c = (i * 64 + lane) * 8; const u32x4 h = hw[rr][i];
                const f32x4 g0 = *(const f32x4*)(p.in[28] + c), g1 = *(const f32x4*)(p.in[28] + c + 4);
                *(f32x4*)(o + c) = (f32x4){bf_lo(h.x), bf_hi(h.x), bf_lo(h.y), bf_hi(h.y)} * rs * g0;
                *(f32x4*)(o + c + 4) = (f32x4){bf_lo(h.z), bf_hi(h.z), bf_lo(h.w), bf_hi(h.w)} * rs * g1; } }
    }
}

extern "C" void kernel_launch(void* const* d_in, const int* in_sizes, int n_in, void* d_out, int out_size, void* d_ws, size_t ws_size, hipStream_t stream) {
    static int grid_blocks = 0;
    if (grid_blocks == 0) {
        if (n_in != 29 || ws_size < WS_END || out_size != T_ALL * DM) { fprintf(stderr, "kernel_launch: unexpected shapes n_in %d ws %zu out %d\n", n_in, ws_size, out_size); grid_blocks = -1; return; }
        int dev = 0, cus = 0, per_cu = 0;
        hipGetDevice(&dev); hipDeviceGetAttribute(&cus, hipDeviceAttributeMultiprocessorCount, dev);
        if (hipFuncSetAttribute((const void*)hybrid_fwd, hipFuncAttributeMaxDynamicSharedMemorySize, LDS_BYTES) != hipSuccess) { fprintf(stderr, "kernel_launch: hipFuncSetAttribute failed\n"); grid_blocks = -1; return; }
        if (hipOccupancyMaxActiveBlocksPerMultiprocessor(&per_cu, (const void*)hybrid_fwd, 512, LDS_BYTES) != hipSuccess || per_cu < 1) { fprintf(stderr, "kernel_launch: occupancy query says %d\n", per_cu); per_cu = 1; }
        (void)hipGetLastError();
        grid_blocks = cus;
    }
    if (grid_blocks < 0) return;
    if (hipMemsetAsync((char*)d_ws + WS_BAR, 0, 16384, stream) != hipSuccess) { fprintf(stderr, "kernel_launch: memset failed\n"); return; }
    Params p{};
    for (int i = 0; i < 29; ++i) p.in[i] = (const float*)d_in[i];
    p.out = (float*)d_out; p.ws = (unsigned char*)d_ws;
    void* args[] = {&p};
    hipError_t e = hipLaunchCooperativeKernel((const void*)hybrid_fwd, dim3(grid_blocks), dim3(512), args, LDS_BYTES, stream);
    if (e != hipSuccess) fprintf(stderr, "cooperative launch failed: %s (grid %d)\n", hipGetErrorString(e), grid_blocks);
}
```
